# Optimizing an MI355X kernel written in HIP

```python
import math
import jax, jax.numpy as jnp
from jax import lax
import numpy as np

D_MODEL = 1024
BATCH = 8
SEQ = 4096
DEPTH = 2

GRID_W = 64
CTX_LEN = 256
N_MOD = 6
EPS = 1e-6

ATT_HEADS = 4
ATT_QK_DIM = 64
ATT_V_DIM = 2 * ATT_QK_DIM
ATT_WIDTH = ATT_HEADS * ATT_V_DIM
QK_COLS = ATT_HEADS * 2 * ATT_QK_DIM
ATT_QBLOCK = 128
ROPE_THETA = 10000.0
ROPE_AXIS_DIM = ATT_QK_DIM // 2

S5_WIDTH = D_MODEL // 4
S5_GROUP = 16
S5_GROUPS = S5_WIDTH // S5_GROUP
S5_STATE = 64

CONV_WIDTH = D_MODEL // 4
CONV_KSIZE = 31

MIX_WIDTH = ATT_WIDTH + S5_WIDTH + CONV_WIDTH
IN_COLS = 2 * QK_COLS + ATT_WIDTH + S5_WIDTH + 2 * CONV_WIDTH

PEER_HEADS = 8
PEER_NKEYS = 128
PEER_EXPERTS = PEER_NKEYS * PEER_NKEYS
PEER_QDIM = 256
PEER_HALF = PEER_QDIM // 2
PEER_TOPK = 16
PEER_CHUNK = 128

kernel_name = "hybrid_diffattn_s5_conformer_peer_block"

F32 = jnp.float32


def rmsnorm(x, g):
    xf = x.astype(F32)
    y = xf * lax.rsqrt(jnp.mean(xf * xf, axis=-1, keepdims=True) + EPS)
    return (y * g.astype(F32)).astype(x.dtype)


def layernorm(x, g, b):
    xf = x.astype(F32)
    mu = jnp.mean(xf, axis=-1, keepdims=True)
    var = jnp.mean(jnp.square(xf - mu), axis=-1, keepdims=True)
    return ((xf - mu) * lax.rsqrt(var + EPS) * g.astype(F32) + b.astype(F32)).astype(x.dtype)


def axial_rope_tables(L):
    rows = L // GRID_W
    row = jnp.broadcast_to(jnp.arange(rows, dtype=F32)[:, None], (rows, GRID_W)).reshape(-1)
    col = jnp.broadcast_to(jnp.arange(GRID_W, dtype=F32)[None, :], (rows, GRID_W)).reshape(-1)
    inv = ROPE_THETA ** (-jnp.arange(0, ROPE_AXIS_DIM, 2, dtype=F32) / ROPE_AXIS_DIM)
    ar = row[:, None] * inv
    ac = col[:, None] * inv
    ang = jnp.concatenate([ar, ar, ac, ac], axis=-1)
    return jnp.cos(ang), jnp.sin(ang)


def apply_axial_rope(x, cos, sin):
    h = ROPE_AXIS_DIM // 2
    r = x[..., :ROPE_AXIS_DIM]
    cc = x[..., ROPE_AXIS_DIM:]
    rot = jnp.concatenate([-r[..., h:], r[..., :h], -cc[..., h:], cc[..., :h]], axis=-1)
    cs = cos[None, :, None, None, :]
    sn = sin[None, :, None, None, :]
    return (x.astype(F32) * cs + rot.astype(F32) * sn).astype(x.dtype)


def split_in(p):
    B, L = p.shape[:2]
    q = p[..., :QK_COLS].reshape(B, L, ATT_HEADS, 2, ATT_QK_DIM)
    k = p[..., QK_COLS:2 * QK_COLS].reshape(B, L, ATT_HEADS, 2, ATT_QK_DIM)
    off = 2 * QK_COLS
    v = p[..., off:off + ATT_WIDTH].reshape(B, L, ATT_HEADS, ATT_V_DIM)
    off = off + ATT_WIDTH
    u = p[..., off:off + S5_WIDTH]
    z = p[..., off + S5_WIDTH:]
    return q, k, v, u, z


def _diff_attend(qb, k, v, lam):
    s = jnp.einsum('bqhmd,bkhmd->bhmqk', qb, k, preferred_element_type=F32) * (1.0 / math.sqrt(ATT_QK_DIM))
    p = jax.nn.softmax(s, axis=-1)
    a = p[:, :, 0] - lam * p[:, :, 1]
    return jnp.einsum('bhqk,bkhe->bqhe', a.astype(v.dtype), v)


def diff_attention(q_lat, k_lat, v_lat, q_ctx, k_ctx, v_ctx, lam, lam_init, subln_g, need_ctx):
    B, L = q_lat.shape[:2]
    k_all = jnp.concatenate([k_ctx, k_lat], axis=1)
    v_all = jnp.concatenate([v_ctx, v_lat], axis=1)
    nb = L // ATT_QBLOCK
    qb = q_lat.reshape(B, nb, ATT_QBLOCK, ATT_HEADS, 2, ATT_QK_DIM).swapaxes(0, 1)
    o = lax.map(lambda q: _diff_attend(q, k_all, v_all, lam), qb)
    o = o.swapaxes(0, 1).reshape(B, L, ATT_HEADS, ATT_V_DIM)
    o_lat = (rmsnorm(o, subln_g) * (1.0 - lam_init)).reshape(B, L, ATT_WIDTH)
    o_ctx = None
    if need_ctx:
        oc = _diff_attend(q_ctx, k_ctx, v_ctx, lam)
        o_ctx = (rmsnorm(oc, subln_g) * (1.0 - lam_init)).reshape(B, q_ctx.shape[1], ATT_WIDTH)
    return o_lat, o_ctx


def _s5_discretize(a_re, a_im, log_dt, b_re, b_im):
    dt = jnp.exp(log_dt)
    mag = jnp.exp(a_re * dt)
    ar = mag * jnp.cos(a_im * dt)
    ai = mag * jnp.sin(a_im * dt)
    xr = ar - 1.0
    den = a_re * a_re + a_im * a_im
    cr = (xr * a_re + ai * a_im) / den
    ci = (ai * a_re - xr * a_im) / den
    bbr = cr[..., None] * b_re - ci[..., None] * b_im
    bbi = cr[..., None] * b_im + ci[..., None] * b_re
    return ar, ai, bbr, bbi


def _s5_combine(e1, e2):
    a1r, a1i, b1r, b1i = e1
    a2r, a2i, b2r, b2i = e2
    ar = a2r * a1r - a2i * a1i
    ai = a2r * a1i + a2i * a1r
    br = a2r * b1r - a2i * b1i + b2r
    bi = a2r * b1i + a2i * b1r + b2i
    return ar, ai, br, bi


def _s5_scan(u, ar, ai, bbr, bbi, h0, reverse):
    L = u.shape[1]
    bu_r = jnp.einsum('blgh,gph->blgp', u, bbr)
    bu_i = jnp.einsum('blgh,gph->blgp', u, bbi)
    if h0 is not None:
        h0r, h0i = h0
        idx = -1 if reverse else 0
        bu_r = bu_r.at[:, idx].add(ar * h0r - ai * h0i)
        bu_i = bu_i.at[:, idx].add(ar * h0i + ai * h0r)
    a_r = jnp.broadcast_to(ar[None, None], (1, L) + ar.shape)
    a_i = jnp.broadcast_to(ai[None, None], (1, L) + ai.shape)
    _, _, hr, hi = lax.associative_scan(_s5_combine, (a_r, a_i, bu_r, bu_i), reverse=reverse, axis=1)
    return hr, hi


def _s5_readout(hr, hi, c_re, c_im):
    return jnp.einsum('blgp,ghp->blgh', hr, c_re) - jnp.einsum('blgp,ghp->blgh', hi, c_im)


def _s5_glu(y, w_glu):
    g = jax.nn.gelu(y)
    return g * jax.nn.sigmoid(g @ w_glu.astype(F32))


def s5_mixer(u_lat, u_ctx, a_re, a_im, log_dt, b_re, b_im, c_re, c_im, d_skip, w_glu, need_ctx):
    B, L, _ = u_lat.shape
    Lc = u_ctx.shape[1]
    ul = u_lat.astype(F32).reshape(B, L, S5_GROUPS, S5_GROUP)
    uc = u_ctx.astype(F32).reshape(B, Lc, S5_GROUPS, S5_GROUP)
    dg = d_skip.astype(F32).reshape(S5_GROUPS, S5_GROUP)
    y_lat = dg * ul
    y_ctx = dg * uc
    for d in range(2):
        rev = d == 1
        ar, ai, bbr, bbi = _s5_discretize(a_re[d].astype(F32), a_im[d].astype(F32), log_dt[d].astype(F32),
                                          b_re[d].astype(F32), b_im[d].astype(F32))
        hcr, hci = _s5_scan(uc, ar, ai, bbr, bbi, None, rev)
        fin = 0 if rev else -1
        hr, hi = _s5_scan(ul, ar, ai, bbr, bbi, (hcr[:, fin], hci[:, fin]), rev)
        cr = c_re[d].astype(F32)
        ci = c_im[d].astype(F32)
        y_lat = y_lat + _s5_readout(hr, hi, cr, ci)
        if need_ctx:
            y_ctx = y_ctx + _s5_readout(hcr, hci, cr, ci)
    out_lat = _s5_glu(y_lat.reshape(B, L, S5_WIDTH), w_glu).astype(u_lat.dtype)
    out_ctx = _s5_glu(y_ctx.reshape(B, Lc, S5_WIDTH), w_glu).astype(u_ctx.dtype) if need_ctx else None
    return out_lat, out_ctx


def conformer_conv(z, w_dw, b_dw, ln_g, ln_b, w_pw, b_pw):
    a, gate = jnp.split(z, 2, axis=-1)
    h = a * jax.nn.sigmoid(gate)
    h = lax.conv_general_dilated(h, w_dw[:, None, :].astype(h.dtype), window_strides=(1,),
                                 padding=[(CONV_KSIZE // 2, CONV_KSIZE // 2)],
                                 dimension_numbers=('NWC', 'WIO', 'NWC'),
                                 feature_group_count=CONV_WIDTH) + b_dw
    h = jax.nn.silu(layernorm(h, ln_g, ln_b))
    return h @ w_pw + b_pw


def peer(h, w_q, subkeys, u_tab, v_tab):
    B, L, D = h.shape
    tok = h.reshape(-1, PEER_CHUNK, D)

    def chunk(xc):
        T = xc.shape[0]
        q = (xc @ w_q).reshape(T, PEER_HEADS, 2, PEER_HALF)
        s = jnp.einsum('thmd,hmnd->thmn', q, subkeys, preferred_element_type=F32)
        sv, si = lax.top_k(s, PEER_TOPK)
        cand = (sv[:, :, 0, :, None] + sv[:, :, 1, None, :]).reshape(T, PEER_HEADS, PEER_TOPK * PEER_TOPK)
        cidx = (si[:, :, 0, :, None] * PEER_NKEYS + si[:, :, 1, None, :]).reshape(T, PEER_HEADS, PEER_TOPK * PEER_TOPK)
        tv, ti = lax.top_k(cand, PEER_TOPK)
        eidx = jnp.take_along_axis(cidx, ti, axis=-1)
        g = jax.nn.softmax(tv, axis=-1)
        u_sel = u_tab[eidx]
        act = jax.nn.gelu(jnp.einsum('td,thkd->thk', xc, u_sel, preferred_element_type=F32))
        w = (g * act).astype(xc.dtype)
        return jnp.einsum('thk,thkd->td', w, v_tab[eidx])

    return lax.map(chunk, tok).reshape(B, L, D)


def setup_inputs(seed: int = 0) -> dict:
    key = jax.random.key(seed)
    ks = iter(jax.random.split(key, 40))

    def nrm(shape, scale):
        return jax.random.normal(next(ks), shape, F32) * scale

    G, P, Hc = S5_GROUPS, S5_STATE, S5_GROUP
    a_im_base = jnp.pi * jnp.arange(P, dtype=F32)
    return {
        'x': nrm((BATCH, SEQ, D_MODEL), 1.0),
        'c': nrm((BATCH, D_MODEL), 1.0),
        'ctx': nrm((BATCH, CTX_LEN, D_MODEL), 1.0),
        'c_ctx': nrm((D_MODEL,), 1.0),
        'w_mod': nrm((DEPTH, D_MODEL, N_MOD * D_MODEL), 0.5 * D_MODEL ** -0.5),
        'b_mod': nrm((DEPTH, N_MOD * D_MODEL), 0.01),
        'g_norm1': 1.0 + nrm((DEPTH, D_MODEL), 0.05),
        'g_norm2': 1.0 + nrm((DEPTH, D_MODEL), 0.05),
        'w_in': nrm((DEPTH, D_MODEL, IN_COLS), D_MODEL ** -0.5),
        'w_out': nrm((DEPTH, MIX_WIDTH, D_MODEL), MIX_WIDTH ** -0.5),
        'attn_lq1': nrm((DEPTH, ATT_QK_DIM), 0.1),
        'attn_lk1': nrm((DEPTH, ATT_QK_DIM), 0.1),
        'attn_lq2': nrm((DEPTH, ATT_QK_DIM), 0.1),
        'attn_lk2': nrm((DEPTH, ATT_QK_DIM), 0.1),
        'attn_subln_g': 1.0 + nrm((DEPTH, ATT_V_DIM), 0.05),
        's5_a_re': -0.5 + nrm((DEPTH, 2, G, P), 0.01),
        's5_a_im': a_im_base + nrm((DEPTH, 2, G, P), 0.01),
        's5_log_dt': jax.random.uniform(next(ks), (DEPTH, 2, G, P), F32, math.log(1e-3), math.log(1e-1)),
        's5_b_re': nrm((DEPTH, 2, G, P, Hc), (2 * Hc) ** -0.5),
        's5_b_im': nrm((DEPTH, 2, G, P, Hc), (2 * Hc) ** -0.5),
        's5_c_re': nrm((DEPTH, 2, G, Hc, P), 0.5),
        's5_c_im': nrm((DEPTH, 2, G, Hc, P), 0.5),
        's5_d': nrm((DEPTH, S5_WIDTH), 1.0),
        's5_w_glu': nrm((DEPTH, S5_WIDTH, S5_WIDTH), S5_WIDTH ** -0.5),
        'conv_dw': nrm((DEPTH, CONV_KSIZE, CONV_WIDTH), CONV_KSIZE ** -0.5),
        'conv_dw_b': nrm((DEPTH, CONV_WIDTH), 0.01),
        'conv_ln_g': 1.0 + nrm((DEPTH, CONV_WIDTH), 0.05),
        'conv_ln_b': nrm((DEPTH, CONV_WIDTH), 0.01),
        'conv_w_pw': nrm((DEPTH, CONV_WIDTH, CONV_WIDTH), CONV_WIDTH ** -0.5),
        'conv_b_pw': nrm((DEPTH, CONV_WIDTH), 0.01),
        'peer_w_q': nrm((DEPTH, D_MODEL, PEER_HEADS * PEER_QDIM), D_MODEL ** -0.5),
        'peer_subkeys': nrm((DEPTH, PEER_HEADS, 2, PEER_NKEYS, PEER_HALF), PEER_HALF ** -0.5),
        'peer_u': nrm((DEPTH, PEER_EXPERTS, D_MODEL), D_MODEL ** -0.5),
        'peer_v': nrm((DEPTH, PEER_EXPERTS, D_MODEL), 0.25),
        'g_final': 1.0 + nrm((D_MODEL,), 0.05),
    }


def reference(x, c, ctx, c_ctx, w_mod, b_mod, g_norm1, g_norm2, w_in, w_out,
              attn_lq1, attn_lk1, attn_lq2, attn_lk2, attn_subln_g,
              s5_a_re, s5_a_im, s5_log_dt, s5_b_re, s5_b_im, s5_c_re, s5_c_im, s5_d, s5_w_glu,
              conv_dw, conv_dw_b, conv_ln_g, conv_ln_b, conv_w_pw, conv_b_pw,
              peer_w_q, peer_subkeys, peer_u, peer_v, g_final):
    L = x.shape[1]
    cos, sin = axial_rope_tables(L)
    x_lat = x
    x_ctx = ctx
    for l in range(DEPTH):
        need_ctx = l < DEPTH - 1
        lam_init = 0.8 - 0.6 * math.exp(-0.3 * l)
        m_lat = jax.nn.silu(c) @ w_mod[l] + b_mod[l]
        m_ctx = jax.nn.silu(c_ctx) @ w_mod[l] + b_mod[l]
        sh1, sc1, gt1, sh2, sc2, gt2 = [t[:, None, :] for t in jnp.split(m_lat, N_MOD, axis=-1)]
        csh1, csc1, cgt1, csh2, csc2, cgt2 = jnp.split(m_ctx, N_MOD, axis=-1)

        h_lat = rmsnorm(x_lat, g_norm1[l]) * (1.0 + sc1) + sh1
        h_ctx = rmsnorm(x_ctx, g_norm1[l]) * (1.0 + csc1) + csh1
        q_l, k_l, v_l, u_l, z_l = split_in(h_lat @ w_in[l])
        q_c, k_c, v_c, u_c, z_c = split_in(h_ctx @ w_in[l])
        q_l = apply_axial_rope(q_l, cos, sin)
        k_l = apply_axial_rope(k_l, cos, sin)
        lam = (jnp.exp(jnp.sum(attn_lq1[l].astype(F32) * attn_lk1[l].astype(F32)))
               - jnp.exp(jnp.sum(attn_lq2[l].astype(F32) * attn_lk2[l].astype(F32))) + lam_init)
        a_lat, a_ctx = diff_attention(q_l, k_l, v_l, q_c, k_c, v_c, lam, lam_init, attn_subln_g[l], need_ctx)
        s_lat, s_ctx = s5_mixer(u_l, u_c, s5_a_re[l], s5_a_im[l], s5_log_dt[l], s5_b_re[l], s5_b_im[l],
                                s5_c_re[l], s5_c_im[l], s5_d[l], s5_w_glu[l], need_ctx)
        cv_lat = conformer_conv(z_l, conv_dw[l], conv_dw_b[l], conv_ln_g[l], conv_ln_b[l], conv_w_pw[l], conv_b_pw[l])
        y_lat = jnp.concatenate([a_lat, s_lat, cv_lat], axis=-1) @ w_out[l]
        x_lat = x_lat + gt1 * y_lat
        if need_ctx:
            cv_ctx = conformer_conv(z_c, conv_dw[l], conv_dw_b[l], conv_ln_g[l], conv_ln_b[l], conv_w_pw[l], conv_b_pw[l])
            y_ctx = jnp.concatenate([a_ctx, s_ctx, cv_ctx], axis=-1) @ w_out[l]
            x_ctx = x_ctx + cgt1 * y_ctx

        h2 = rmsnorm(x_lat, g_norm2[l]) * (1.0 + sc2) + sh2
        x_lat = x_lat + gt2 * peer(h2, peer_w_q[l], peer_subkeys[l], peer_u[l], peer_v[l])
        if need_ctx:
            h2c = rmsnorm(x_ctx, g_norm2[l]) * (1.0 + csc2) + csh2
            x_ctx = x_ctx + cgt2 * peer(h2c, peer_w_q[l], peer_subkeys[l], peer_u[l], peer_v[l])
    return rmsnorm(x_lat, g_final)
```

```cpp
#include <hip/hip_runtime.h>
#include <hip/hip_cooperative_groups.h>
#include <cstdio>
#include <cstdint>
namespace cg = cooperative_groups;

typedef unsigned short u16;
typedef __attribute__((ext_vector_type(8))) short bf16x8;
typedef __attribute__((ext_vector_type(4))) float f32x4;
typedef __attribute__((ext_vector_type(16))) float f32x16;
typedef __attribute__((ext_vector_type(2))) __bf16 bf16x2_t;

#define DM 1024
#define NB 8
#define LSEQ 4096
#define LCTX 256
#define SB 4352
#define NT (NB * SB)
#define NTHREADS 256
#define HLD 1088
#define SMEM_BYTES 77824

constexpr size_t SZ_XC = (size_t)NB * LCTX * DM * 4;
constexpr size_t SZ_HBUF = (size_t)NT * HLD * 2;
constexpr size_t SZ_QB = (size_t)NT * 512 * 2;
constexpr size_t SZ_UB = (size_t)NT * 256 * 2;
constexpr size_t SZ_Y = (size_t)NT * 256 * 4;
constexpr size_t OFF_XC = 0;
constexpr size_t OFF_HBUF = OFF_XC + SZ_XC;
constexpr size_t OFF_QB = OFF_HBUF + SZ_HBUF;
constexpr size_t OFF_KB = OFF_QB + SZ_QB;
constexpr size_t OFF_VT = OFF_KB + SZ_QB;
constexpr size_t OFF_UB = OFF_VT + SZ_QB;
constexpr size_t OFF_ZB = OFF_UB + SZ_UB;
constexpr size_t OFF_YF = OFF_ZB + SZ_QB;
constexpr size_t OFF_YB = OFF_YF + SZ_Y;
constexpr size_t OFF_CVIN = OFF_YB + SZ_Y;
constexpr size_t OFF_WINT = OFF_CVIN + SZ_UB;
constexpr size_t OFF_WOUTT = OFF_WINT + (size_t)2 * 2304 * HLD * 2;
constexpr size_t OFF_WQT = OFF_WOUTT + (size_t)2 * 1024 * HLD * 2;
constexpr size_t OFF_WGLUT = OFF_WQT + (size_t)2 * 2048 * HLD * 2;
constexpr size_t OFF_WPWT = OFF_WGLUT + (size_t)2 * 256 * 256 * 2;
constexpr size_t OFF_SUBK = OFF_WPWT + (size_t)2 * 256 * 256 * 2;
constexpr size_t OFF_UTAB = OFF_SUBK + (size_t)2 * 8 * 2 * 128 * 128 * 2;
constexpr size_t OFF_VTAB = OFF_UTAB + (size_t)2 * 16384 * 1024;
constexpr size_t OFF_USC = OFF_VTAB + (size_t)2 * 16384 * 1024;
constexpr size_t OFF_VSC = OFF_USC + (size_t)2 * 16384 * 4;
constexpr size_t OFF_MLAT = OFF_VSC + (size_t)2 * 16384 * 4;
constexpr size_t OFF_MCTX = OFF_MLAT + (size_t)2 * 8 * 6144 * 4;
constexpr size_t OFF_S5A = OFF_MCTX + (size_t)2 * 6144 * 4;
constexpr size_t OFF_S5BB = OFF_S5A + (size_t)2 * 4096 * 4;
constexpr size_t OFF_ROPE = OFF_S5BB + (size_t)2 * 65536 * 4;
constexpr size_t OFF_CNT = OFF_ROPE + (size_t)2 * 1024 * 4;
constexpr size_t OFF_G = OFF_CNT + 256;
constexpr size_t OFF_BAR = OFF_G + SZ_UB;
constexpr size_t WS_TOTAL = OFF_BAR + 16384;

struct Params {
  const float* in[35];
  float* out;
  char* ws;
};

__device__ __forceinline__ uint32_t pack2(float a, float b) {
  bf16x2_t r; r[0] = (__bf16)a; r[1] = (__bf16)b; return __builtin_bit_cast(uint32_t, r);
}
__device__ __forceinline__ u16 f2bf(float a) { return (u16)(pack2(a, 0.f) & 0xFFFFu); }
__device__ __forceinline__ float bflo(uint32_t u) { return __uint_as_float(u << 16); }
__device__ __forceinline__ float bfhi(uint32_t u) { return __uint_as_float(u & 0xFFFF0000u); }
__device__ __forceinline__ float bf2f(u16 h) { return __uint_as_float(((uint32_t)h) << 16); }
__device__ __forceinline__ float sigmoidf_(float x) { return 1.f / (1.f + __expf(-x)); }
__device__ __forceinline__ float siluf_(float x) { return x * sigmoidf_(x); }
__device__ __forceinline__ float gelu_tanh(float x) {
  float z = 0.7978845608028654f * (x + 0.044715f * x * x * x);
  float t = 1.f - 2.f / (__expf(2.f * z) + 1.f);
  return 0.5f * x * (1.f + t);
}
__device__ __forceinline__ float wave_sum(float v) {
#pragma unroll
  for (int o = 32; o >= 1; o >>= 1) v += __shfl_xor(v, o);
  return v;
}
__device__ __forceinline__ float dot2bf(uint32_t a, uint32_t b, float c) {
  return __builtin_amdgcn_fdot2_f32_bf16(__builtin_bit_cast(bf16x2_t, a), __builtin_bit_cast(bf16x2_t, b), c, false);
}

#ifndef U_FP4
#define U_FP4 1
#endif
#ifndef V_FP4
#define V_FP4 1
#endif
typedef __attribute__((ext_vector_type(2))) float f2;
struct Row8 { int4 v; };
struct Row4 { uint2 v; };
__device__ __forceinline__ void dec_row(const Row8& r, f2 (&o)[8]) {
  o[0] = __builtin_amdgcn_cvt_pk_f32_fp8(r.v.x, false); o[1] = __builtin_amdgcn_cvt_pk_f32_fp8(r.v.x, true);
  o[2] = __builtin_amdgcn_cvt_pk_f32_fp8(r.v.y, false); o[3] = __builtin_amdgcn_cvt_pk_f32_fp8(r.v.y, true);
  o[4] = __builtin_amdgcn_cvt_pk_f32_fp8(r.v.z, false); o[5] = __builtin_amdgcn_cvt_pk_f32_fp8(r.v.z, true);
  o[6] = __builtin_amdgcn_cvt_pk_f32_fp8(r.v.w, false); o[7] = __builtin_amdgcn_cvt_pk_f32_fp8(r.v.w, true);
}
__device__ __forceinline__ void dec_row(const Row4& r, f2 (&o)[8]) {
  o[0] = __builtin_amdgcn_cvt_scalef32_pk_f32_fp4(r.v.x, 1.0f, 0); o[1] = __builtin_amdgcn_cvt_scalef32_pk_f32_fp4(r.v.x, 1.0f, 1);
  o[2] = __builtin_amdgcn_cvt_scalef32_pk_f32_fp4(r.v.x, 1.0f, 2); o[3] = __builtin_amdgcn_cvt_scalef32_pk_f32_fp4(r.v.x, 1.0f, 3);
  o[4] = __builtin_amdgcn_cvt_scalef32_pk_f32_fp4(r.v.y, 1.0f, 0); o[5] = __builtin_amdgcn_cvt_scalef32_pk_f32_fp4(r.v.y, 1.0f, 1);
  o[6] = __builtin_amdgcn_cvt_scalef32_pk_f32_fp4(r.v.y, 1.0f, 2); o[7] = __builtin_amdgcn_cvt_scalef32_pk_f32_fp4(r.v.y, 1.0f, 3);
}
__device__ __forceinline__ void load_row(Row8& r, const unsigned char* tab, int e, int lane) { r.v = *(const int4*)(tab + (size_t)e * 1024 + lane * 16); }
__device__ __forceinline__ void load_row(Row4& r, const unsigned char* tab, int e, int lane) { r.v = *(const uint2*)(tab + (size_t)e * 512 + lane * 8); }
#if U_FP4
typedef Row4 URow;
#define U_ROWB 512
#else
typedef Row8 URow;
#define U_ROWB 1024
#endif
#if V_FP4
typedef Row4 VRow;
#define V_ROWB 512
#else
typedef Row8 VRow;
#define V_ROWB 1024
#endif

__device__ __forceinline__ int otid() { int t = __builtin_amdgcn_workitem_id_x(); asm volatile("" : "+v"(t)); return t; }
__device__ __forceinline__ int opaque_zero() { int z = 0; asm volatile("" : "+s"(z)); return z; }

__device__ __forceinline__ const float* res_src(const Params& p, int l, int g) {
  int b = g / SB, s = g - b * SB;
  if (s < LCTX) return (l == 0 ? p.in[2] : (const float*)(p.ws + OFF_XC)) + ((size_t)(b * LCTX + s)) * DM;
  return (l == 0 ? p.in[0] : (const float*)p.out) + ((size_t)(b * LSEQ + s - LCTX)) * DM;
}
__device__ __forceinline__ float* res_dst(const Params& p, int g) {
  int b = g / SB, s = g - b * SB;
  if (s < LCTX) return (float*)(p.ws + OFF_XC) + ((size_t)(b * LCTX + s)) * DM;
  return p.out + ((size_t)(b * LSEQ + s - LCTX)) * DM;
}
__device__ __forceinline__ const float* mod_vec(const Params& p, int l, int g) {
  int b = g / SB, s = g - b * SB;
  if (s < LCTX) return (const float*)(p.ws + OFF_MCTX) + (size_t)l * 6144;
  return (const float*)(p.ws + OFF_MLAT) + ((size_t)l * 8 + b) * 6144;
}

struct Loc { int xq, lb, nl; };

__device__ __forceinline__ void transpose_convert_tile(const float* src, int K, int N, u16* dst, int ldd, int k0, int n0, float* sm) {
  int tid = otid();
  __syncthreads();
#pragma unroll
  for (int ps = 0; ps < 4; ps++) {
    int r = ps * 16 + (tid >> 4), c4 = (tid & 15) * 4;
    float4 v = *(const float4*)(src + (size_t)(k0 + r) * N + n0 + c4);
    sm[r * 65 + c4 + 0] = v.x; sm[r * 65 + c4 + 1] = v.y; sm[r * 65 + c4 + 2] = v.z; sm[r * 65 + c4 + 3] = v.w;
  }
  __syncthreads();
  int n = tid >> 2, kq = (tid & 3) * 16;
  uint32_t pk[8];
#pragma unroll
  for (int i = 0; i < 8; i++) pk[i] = pack2(sm[(kq + 2 * i) * 65 + n], sm[(kq + 2 * i + 1) * 65 + n]);
  uint4* d = (uint4*)(dst + (size_t)(n0 + n) * ldd + k0 + kq);
  d[0] = make_uint4(pk[0], pk[1], pk[2], pk[3]);
  d[1] = make_uint4(pk[4], pk[5], pk[6], pk[7]);
}

__device__ __forceinline__ void mod_item(const Params& p, int item, float* sm) {
  int l = item / 96, cg = item % 96;
  int tid = otid();
  float* sc = sm;
  float* red = sm + 9 * 1024;
  __syncthreads();
  for (int idx = tid; idx < 9 * 1024; idx += NTHREADS) {
    int r = idx >> 10, k = idx & 1023;
    float v = (r < 8) ? p.in[1][r * 1024 + k] : p.in[3][k];
    sc[idx] = siluf_(v);
  }
  __syncthreads();
  int kg = tid >> 6, col = tid & 63;
  const float* w = p.in[4] + (size_t)l * 1024 * 6144 + cg * 64 + col;
  float acc[9];
#pragma unroll
  for (int r = 0; r < 9; r++) acc[r] = 0.f;
  for (int k0 = kg * 256; k0 < kg * 256 + 256; k0 += 16) {
    float wv[16];
#pragma unroll
    for (int u = 0; u < 16; u++) wv[u] = w[(size_t)(k0 + u) * 6144];
#pragma unroll
    for (int u = 0; u < 16; u += 4) {
#pragma unroll
      for (int r = 0; r < 9; r++) {
        float4 s4 = *(const float4*)(sc + r * 1024 + k0 + u);
        acc[r] += s4.x * wv[u] + s4.y * wv[u + 1] + s4.z * wv[u + 2] + s4.w * wv[u + 3];
      }
    }
  }
#pragma unroll
  for (int r = 0; r < 9; r++) red[(kg * 9 + r) * 64 + col] = acc[r];
  __syncthreads();
  for (int idx = tid; idx < 9 * 64; idx += NTHREADS) {
    int r = idx >> 6, c = idx & 63;
    float s = red[(0 * 9 + r) * 64 + c] + red[(1 * 9 + r) * 64 + c] + red[(2 * 9 + r) * 64 + c] + red[(3 * 9 + r) * 64 + c];
    s += p.in[5][l * 6144 + cg * 64 + c];
    if (r < 8) ((float*)(p.ws + OFF_MLAT))[((size_t)l * 8 + r) * 6144 + cg * 64 + c] = s;
    else ((float*)(p.ws + OFF_MCTX))[(size_t)l * 6144 + cg * 64 + c] = s;
  }
}

__device__ __forceinline__ void s5disc_item(const Params& p, int item) {
  int idx = item * NTHREADS + otid();
  if (idx >= 4096) return;
  float a_re = p.in[15][idx], a_im = p.in[16][idx], ldt = p.in[17][idx];
  float dt = expf(ldt);
  float mag = expf(a_re * dt);
  float ar = mag * cosf(a_im * dt), ai = mag * sinf(a_im * dt);
  float xr = ar - 1.f;
  float den = a_re * a_re + a_im * a_im;
  float cr = (xr * a_re + ai * a_im) / den;
  float ci = (ai * a_re - xr * a_im) / den;
  float* A = (float*)(p.ws + OFF_S5A);
  A[idx] = ar; A[4096 + idx] = ai;
  float* BB = (float*)(p.ws + OFF_S5BB);
#pragma unroll
  for (int h = 0; h < 16; h++) {
    float br = p.in[18][(size_t)idx * 16 + h], bi = p.in[19][(size_t)idx * 16 + h];
    BB[(size_t)idx * 16 + h] = cr * br - ci * bi;
    BB[65536 + (size_t)idx * 16 + h] = cr * bi + ci * br;
  }
}

__device__ __forceinline__ void convert_chunk(const float* src, u16* dst, size_t base) {
#pragma unroll
  for (int ps = 0; ps < 4; ps++) {
    size_t o = base + (size_t)ps * 2048 + (size_t)otid() * 8;
    float4 a = *(const float4*)(src + o), b = *(const float4*)(src + o + 4);
    *(uint4*)(dst + o) = make_uint4(pack2(a.x, a.y), pack2(a.z, a.w), pack2(b.x, b.y), pack2(b.z, b.w));
  }
}

__device__ __forceinline__ void fp8_rows_item(const float* src, unsigned char* dst, float* scl, int row0) {
  int tid = otid(), lane = tid & 63, w = tid >> 6;
  int row = row0 + w;
  const float* s = src + (size_t)row * 1024 + lane * 16;
  float4 a = *(const float4*)(s), b = *(const float4*)(s + 4), c = *(const float4*)(s + 8), d = *(const float4*)(s + 12);
  float mx = fmaxf(fmaxf(fmaxf(fabsf(a.x), fabsf(a.y)), fmaxf(fabsf(a.z), fabsf(a.w))), fmaxf(fmaxf(fabsf(b.x), fabsf(b.y)), fmaxf(fabsf(b.z), fabsf(b.w))));
  mx = fmaxf(mx, fmaxf(fmaxf(fmaxf(fabsf(c.x), fabsf(c.y)), fmaxf(fabsf(c.z), fabsf(c.w))), fmaxf(fmaxf(fabsf(d.x), fabsf(d.y)), fmaxf(fabsf(d.z), fabsf(d.w)))));
#pragma unroll
  for (int o = 32; o >= 1; o >>= 1) mx = fmaxf(mx, __shfl_xor(mx, o));
  float sc = (mx > 0.f) ? 224.f / mx : 1.f;
  int p0 = __builtin_amdgcn_cvt_pk_fp8_f32(a.x * sc, a.y * sc, 0, false); p0 = __builtin_amdgcn_cvt_pk_fp8_f32(a.z * sc, a.w * sc, p0, true);
  int p1 = __builtin_amdgcn_cvt_pk_fp8_f32(b.x * sc, b.y * sc, 0, false); p1 = __builtin_amdgcn_cvt_pk_fp8_f32(b.z * sc, b.w * sc, p1, true);
  int p2 = __builtin_amdgcn_cvt_pk_fp8_f32(c.x * sc, c.y * sc, 0, false); p2 = __builtin_amdgcn_cvt_pk_fp8_f32(c.z * sc, c.w * sc, p2, true);
  int p3 = __builtin_amdgcn_cvt_pk_fp8_f32(d.x * sc, d.y * sc, 0, false); p3 = __builtin_amdgcn_cvt_pk_fp8_f32(d.z * sc, d.w * sc, p3, true);
  *(int4*)(dst + (size_t)row * 1024 + lane * 16) = make_int4(p0, p1, p2, p3);
  if (lane == 0) scl[row] = (mx > 0.f) ? mx / 224.f : 1.f;
}

__device__ __forceinline__ void fp4_rows_item(const float* src, unsigned char* dst, float* scl, int row0) {
  int tid = otid(), lane = tid & 63, w = tid >> 6;
  int row = row0 + w;
  const float* s = src + (size_t)row * 1024 + lane * 16;
  float4 a = *(const float4*)(s), b = *(const float4*)(s + 4), c = *(const float4*)(s + 8), d = *(const float4*)(s + 12);
  float mx = fmaxf(fmaxf(fmaxf(fabsf(a.x), fabsf(a.y)), fmaxf(fabsf(a.z), fabsf(a.w))), fmaxf(fmaxf(fabsf(b.x), fabsf(b.y)), fmaxf(fabsf(b.z), fabsf(b.w))));
  mx = fmaxf(mx, fmaxf(fmaxf(fmaxf(fabsf(c.x), fabsf(c.y)), fmaxf(fabsf(c.z), fabsf(c.w))), fmaxf(fmaxf(fabsf(d.x), fabsf(d.y)), fmaxf(fabsf(d.z), fabsf(d.w)))));
#pragma unroll
  for (int o = 32; o >= 1; o >>= 1) mx = fmaxf(mx, __shfl_xor(mx, o));
  float sc = (mx > 0.f) ? 6.f / mx : 1.f;
  unsigned p0 = 0, p1 = 0;
  p0 = __builtin_amdgcn_cvt_scalef32_pk_fp4_f32(p0, a.x * sc, a.y * sc, 1.0f, 0);
  p0 = __builtin_amdgcn_cvt_scalef32_pk_fp4_f32(p0, a.z * sc, a.w * sc, 1.0f, 1);
  p0 = __builtin_amdgcn_cvt_scalef32_pk_fp4_f32(p0, b.x * sc, b.y * sc, 1.0f, 2);
  p0 = __builtin_amdgcn_cvt_scalef32_pk_fp4_f32(p0, b.z * sc, b.w * sc, 1.0f, 3);
  p1 = __builtin_amdgcn_cvt_scalef32_pk_fp4_f32(p1, c.x * sc, c.y * sc, 1.0f, 0);
  p1 = __builtin_amdgcn_cvt_scalef32_pk_fp4_f32(p1, c.z * sc, c.w * sc, 1.0f, 1);
  p1 = __builtin_amdgcn_cvt_scalef32_pk_fp4_f32(p1, d.x * sc, d.y * sc, 1.0f, 2);
  p1 = __builtin_amdgcn_cvt_scalef32_pk_fp4_f32(p1, d.z * sc, d.w * sc, 1.0f, 3);
  *(uint2*)(dst + (size_t)row * 1024 + lane * 16) = make_uint2(p0, p1);
  if (lane == 0) scl[row] = (mx > 0.f) ? mx / 6.f : 1.f;
}

__device__ __forceinline__ void fp4_uv_item(const float* usrc, const float* vsrc, unsigned char* dst, float* usc, float* vsc, int row0) {
  int tid = otid(), lane = tid & 63, w = tid >> 6;
  int row = row0 + w;
  const float* su = usrc + (size_t)row * 1024 + lane * 16;
  const float* sv = vsrc + (size_t)row * 1024 + lane * 16;
  float4 a[4], b[4];
#pragma unroll
  for (int q = 0; q < 4; q++) { a[q] = *(const float4*)(su + q * 4); b[q] = *(const float4*)(sv + q * 4); }
  float mu = 0.f, mv = 0.f;
#pragma unroll
  for (int q = 0; q < 4; q++) {
    mu = fmaxf(mu, fmaxf(fmaxf(fabsf(a[q].x), fabsf(a[q].y)), fmaxf(fabsf(a[q].z), fabsf(a[q].w))));
    mv = fmaxf(mv, fmaxf(fmaxf(fabsf(b[q].x), fabsf(b[q].y)), fmaxf(fabsf(b[q].z), fabsf(b[q].w))));
  }
#pragma unroll
  for (int o = 32; o >= 1; o >>= 1) { mu = fmaxf(mu, __shfl_xor(mu, o)); mv = fmaxf(mv, __shfl_xor(mv, o)); }
  float su_ = (mu > 0.f) ? 6.f / mu : 1.f, sv_ = (mv > 0.f) ? 6.f / mv : 1.f;
  unsigned p0 = 0, p1 = 0, p2 = 0, p3 = 0;
  p0 = __builtin_amdgcn_cvt_scalef32_pk_fp4_f32(p0, a[0].x * su_, a[0].y * su_, 1.0f, 0);
  p0 = __builtin_amdgcn_cvt_scalef32_pk_fp4_f32(p0, a[0].z * su_, a[0].w * su_, 1.0f, 1);
  p0 = __builtin_amdgcn_cvt_scalef32_pk_fp4_f32(p0, a[1].x * su_, a[1].y * su_, 1.0f, 2);
  p0 = __builtin_amdgcn_cvt_scalef32_pk_fp4_f32(p0, a[1].z * su_, a[1].w * su_, 1.0f, 3);
  p1 = __builtin_amdgcn_cvt_scalef32_pk_fp4_f32(p1, a[2].x * su_, a[2].y * su_, 1.0f, 0);
  p1 = __builtin_amdgcn_cvt_scalef32_pk_fp4_f32(p1, a[2].z * su_, a[2].w * su_, 1.0f, 1);
  p1 = __builtin_amdgcn_cvt_scalef32_pk_fp4_f32(p1, a[3].x * su_, a[3].y * su_, 1.0f, 2);
  p1 = __builtin_amdgcn_cvt_scalef32_pk_fp4_f32(p1, a[3].z * su_, a[3].w * su_, 1.0f, 3);
  p2 = __builtin_amdgcn_cvt_scalef32_pk_fp4_f32(p2, b[0].x * sv_, b[0].y * sv_, 1.0f, 0);
  p2 = __builtin_amdgcn_cvt_scalef32_pk_fp4_f32(p2, b[0].z * sv_, b[0].w * sv_, 1.0f, 1);
  p2 = __builtin_amdgcn_cvt_scalef32_pk_fp4_f32(p2, b[1].x * sv_, b[1].y * sv_, 1.0f, 2);
  p2 = __builtin_amdgcn_cvt_scalef32_pk_fp4_f32(p2, b[1].z * sv_, b[1].w * sv_, 1.0f, 3);
  p3 = __builtin_amdgcn_cvt_scalef32_pk_fp4_f32(p3, b[2].x * sv_, b[2].y * sv_, 1.0f, 0);
  p3 = __builtin_amdgcn_cvt_scalef32_pk_fp4_f32(p3, b[2].z * sv_, b[2].w * sv_, 1.0f, 1);
  p3 = __builtin_amdgcn_cvt_scalef32_pk_fp4_f32(p3, b[3].x * sv_, b[3].y * sv_, 1.0f, 2);
  p3 = __builtin_amdgcn_cvt_scalef32_pk_fp4_f32(p3, b[3].z * sv_, b[3].w * sv_, 1.0f, 3);
  *(uint4*)(dst + (size_t)row * 1024 + lane * 16) = make_uint4(p0, p1, p2, p3);
  if (lane == 0) { usc[row] = (mu > 0.f) ? mu / 6.f : 1.f; vsc[row] = (mv > 0.f) ? mv / 6.f : 1.f; }
}

__device__ __forceinline__ void phase_prep(const Params& p, float* sm) {
  const int T_PER_L = 576 + 256 + 512 + 16 + 16;
  const int N_T = 2 * T_PER_L;
  const int N_M = 192;
  const int N_S = 16 + 1 + 1;
  const int N_E = 64 + 8192;
  const int total = N_M + N_T + N_S + N_E;
  for (int it = blockIdx.x; it < total; it += gridDim.x) {
    int item = it;
    if (item < N_M) {
      mod_item(p, item, sm);
      asm volatile("s_waitcnt vmcnt(0)" ::: "memory");
      __syncthreads();
      if (otid() == 0) {
        __builtin_amdgcn_fence(__ATOMIC_RELEASE, "agent");
        asm volatile("s_waitcnt vmcnt(0)" ::: "memory");
        __hip_atomic_fetch_add((int*)(p.ws + OFF_BAR + 15360), 1, __ATOMIC_RELAXED, __HIP_MEMORY_SCOPE_AGENT);
      }
      continue;
    }
    item -= N_M;
    if (item < N_T) {
      int l = item / T_PER_L, r = item % T_PER_L;
      if (r < 576) {
        transpose_convert_tile(p.in[8] + (size_t)l * 1024 * 2304, 1024, 2304, (u16*)(p.ws + OFF_WINT) + (size_t)l * 2304 * HLD, HLD, (r / 36) * 64, (r % 36) * 64, sm);
      } else if (r < 832) {
        r -= 576;
        transpose_convert_tile(p.in[9] + (size_t)l * 1024 * 1024, 1024, 1024, (u16*)(p.ws + OFF_WOUTT) + (size_t)l * 1024 * HLD, HLD, (r / 16) * 64, (r % 16) * 64, sm);
      } else if (r < 1344) {
        r -= 832;
        transpose_convert_tile(p.in[30] + (size_t)l * 1024 * 2048, 1024, 2048, (u16*)(p.ws + OFF_WQT) + (size_t)l * 2048 * HLD, HLD, (r / 32) * 64, (r % 32) * 64, sm);
      } else if (r < 1360) {
        r -= 1344;
        transpose_convert_tile(p.in[23] + (size_t)l * 256 * 256, 256, 256, (u16*)(p.ws + OFF_WGLUT) + (size_t)l * 256 * 256, 256, (r / 4) * 64, (r % 4) * 64, sm);
      } else {
        r -= 1360;
        transpose_convert_tile(p.in[28] + (size_t)l * 256 * 256, 256, 256, (u16*)(p.ws + OFF_WPWT) + (size_t)l * 256 * 256, 256, (r / 4) * 64, (r % 4) * 64, sm);
      }
      continue;
    }
    item -= N_T;
    if (item < N_S) {
      if (item < 16) s5disc_item(p, item);
      else if (item == 16) {
        float* R = (float*)(p.ws + OFF_ROPE);
        for (int idx = otid(); idx < 1024; idx += NTHREADS) {
          int pos = idx >> 4, f = idx & 15;
          float inv = powf(10000.0f, -(float)(2 * f) / 32.0f);
          float ang = (float)pos * inv;
          R[idx] = cosf(ang); R[1024 + idx] = sinf(ang);
        }
      } else {
        if (otid() < 64) ((int*)(p.ws + OFF_CNT))[otid()] = 0;
      }
      continue;
    }
    item -= N_S;
    if (item < 64) convert_chunk(p.in[31], (u16*)(p.ws + OFF_SUBK), (size_t)item * 8192);
    else fp4_uv_item(p.in[32], p.in[33], (unsigned char*)(p.ws + OFF_UTAB), (float*)(p.ws + OFF_USC), (float*)(p.ws + OFF_VSC), (item - 64) * 4);
  }
}

__device__ __forceinline__ void norm_write(const float4 (&v)[4], float r, const float* gn, const float* mv, int sh_off, int sc_off, u16* hrow, int lane) {
#pragma unroll
  for (int i = 0; i < 4; i++) {
    int idx = i * 256 + lane * 4;
    float4 g = *(const float4*)(gn + idx);
    float4 sc = *(const float4*)(mv + sc_off + idx);
    float4 sh = *(const float4*)(mv + sh_off + idx);
    float h0 = v[i].x * r * g.x * (1.f + sc.x) + sh.x;
    float h1 = v[i].y * r * g.y * (1.f + sc.y) + sh.y;
    float h2 = v[i].z * r * g.z * (1.f + sc.z) + sh.z;
    float h3 = v[i].w * r * g.w * (1.f + sc.w) + sh.w;
    *(uint2*)(hrow + idx) = make_uint2(pack2(h0, h1), pack2(h2, h3));
  }
}

__device__ __forceinline__ void phase_norm(const Params& p, int l, int which, bool lat_only) {
  int lane = otid() & 63;
  int wid = blockIdx.x * 4 + (otid() >> 6);
  int nw = gridDim.x * 4;
  int ntok = lat_only ? NB * LSEQ : NT;
  const float* gn = p.in[which == 0 ? 6 : 7] + (size_t)l * DM;
  for (int t = wid; t < ntok; t += nw) {
    int g = lat_only ? ((t >> 12) * SB + LCTX + (t & 4095)) : t;
    const float* xr = (which == 0) ? res_src(p, l, g) : (const float*)res_dst(p, g);
    float4 v[4];
    float ss = 0.f;
#pragma unroll
    for (int i = 0; i < 4; i++) {
      v[i] = *(const float4*)(xr + i * 256 + lane * 4);
      ss += v[i].x * v[i].x + v[i].y * v[i].y + v[i].z * v[i].z + v[i].w * v[i].w;
    }
    ss = wave_sum(ss);
    float r = rsqrtf(ss * (1.f / 1024.f) + 1e-6f);
    const float* mv = mod_vec(p, l, g);
    norm_write(v, r, gn, mv, which == 0 ? 0 : 3072, which == 0 ? 1024 : 4096, (u16*)(p.ws + OFF_HBUF) + (size_t)g * HLD, lane);
  }
}

#define LDT 72

__device__ __forceinline__ void mma_step(const u16* As, int lda, const u16* Bs, int ldb, int kofs, int wm, int wn, int lane, f32x4 (&acc)[4][4]) {
  bf16x8 af[4], bfr[4];
#pragma unroll
  for (int i = 0; i < 4; i++) af[i] = *(const bf16x8*)(As + (wm * 64 + i * 16 + (lane & 15)) * lda + kofs + (lane >> 4) * 8);
#pragma unroll
  for (int j = 0; j < 4; j++) bfr[j] = *(const bf16x8*)(Bs + (wn * 64 + j * 16 + (lane & 15)) * ldb + kofs + (lane >> 4) * 8);
#pragma unroll
  for (int i = 0; i < 4; i++)
#pragma unroll
    for (int j = 0; j < 4; j++) acc[i][j] = __builtin_amdgcn_mfma_f32_16x16x32_bf16(af[i], bfr[j], acc[i][j], 0, 0, 0);
}

struct S5Src { const u16* ub; const float* yf; const float* yb; const float* d; };

__device__ __forceinline__ float s5_y(const S5Src& s, int g, int k) {
  return s.d[k] * bf2f(s.ub[(size_t)g * 256 + k]) + s.yf[(size_t)g * 256 + k] + s.yb[(size_t)g * 256 + k];
}

template <int AMODE>
__device__ __forceinline__ void gemm_load(const u16* A, int lda, const S5Src& s5, const u16* Bt, int ldb, int m0, int n0, int k0,
                                          int lr, int lk, uint4& ra0, uint4& ra1, uint4& ra2, uint4& ra3,
                                          uint4& rb0, uint4& rb1, uint4& rb2, uint4& rb3) {
  if (AMODE == 0) {
    ra0 = *(const uint4*)(A + (size_t)(m0 + lr) * lda + k0 + lk);
    ra1 = *(const uint4*)(A + (size_t)(m0 + 32 + lr) * lda + k0 + lk);
    ra2 = *(const uint4*)(A + (size_t)(m0 + 64 + lr) * lda + k0 + lk);
    ra3 = *(const uint4*)(A + (size_t)(m0 + 96 + lr) * lda + k0 + lk);
  } else {
    int k = k0 + lk;
    {
      int g = m0 + lr;
      ra0 = make_uint4(pack2(gelu_tanh(s5_y(s5, g, k)), gelu_tanh(s5_y(s5, g, k + 1))), pack2(gelu_tanh(s5_y(s5, g, k + 2)), gelu_tanh(s5_y(s5, g, k + 3))),
                       pack2(gelu_tanh(s5_y(s5, g, k + 4)), gelu_tanh(s5_y(s5, g, k + 5))), pack2(gelu_tanh(s5_y(s5, g, k + 6)), gelu_tanh(s5_y(s5, g, k + 7))));
      g += 32;
      ra1 = make_uint4(pack2(gelu_tanh(s5_y(s5, g, k)), gelu_tanh(s5_y(s5, g, k + 1))), pack2(gelu_tanh(s5_y(s5, g, k + 2)), gelu_tanh(s5_y(s5, g, k + 3))),
                       pack2(gelu_tanh(s5_y(s5, g, k + 4)), gelu_tanh(s5_y(s5, g, k + 5))), pack2(gelu_tanh(s5_y(s5, g, k + 6)), gelu_tanh(s5_y(s5, g, k + 7))));
      g += 32;
      ra2 = make_uint4(pack2(gelu_tanh(s5_y(s5, g, k)), gelu_tanh(s5_y(s5, g, k + 1))), pack2(gelu_tanh(s5_y(s5, g, k + 2)), gelu_tanh(s5_y(s5, g, k + 3))),
                       pack2(gelu_tanh(s5_y(s5, g, k + 4)), gelu_tanh(s5_y(s5, g, k + 5))), pack2(gelu_tanh(s5_y(s5, g, k + 6)), gelu_tanh(s5_y(s5, g, k + 7))));
      g += 32;
      ra3 = make_uint4(pack2(gelu_tanh(s5_y(s5, g, k)), gelu_tanh(s5_y(s5, g, k + 1))), pack2(gelu_tanh(s5_y(s5, g, k + 2)), gelu_tanh(s5_y(s5, g, k + 3))),
                       pack2(gelu_tanh(s5_y(s5, g, k + 4)), gelu_tanh(s5_y(s5, g, k + 5))), pack2(gelu_tanh(s5_y(s5, g, k + 6)), gelu_tanh(s5_y(s5, g, k + 7))));
    }
  }
  rb0 = *(const uint4*)(Bt + (size_t)(n0 + lr) * ldb + k0 + lk);
  rb1 = *(const uint4*)(Bt + (size_t)(n0 + 32 + lr) * ldb + k0 + lk);
  rb2 = *(const uint4*)(Bt + (size_t)(n0 + 64 + lr) * ldb + k0 + lk);
  rb3 = *(const uint4*)(Bt + (size_t)(n0 + 96 + lr) * ldb + k0 + lk);
}

template <int AMODE>
__device__ __forceinline__ void gemm_main(const u16* A, int lda, const S5Src& s5, const u16* Bt, int ldb, int K, int m0, int n0,
                                          f32x4 (&acc)[4][4], u16* As, u16* Bs) {
  (void)Bs;
  int tid = otid(), lane = tid & 63, w = tid >> 6, wm = w >> 1, wn = w & 1;
  int lr = tid >> 3, lk = (tid & 7) * 8;
  u16* buf = As;
  const int BUFSZ = 128 * LDT;
  uint4 ra0, ra1, ra2, ra3, rb0, rb1, rb2, rb3;
  const int nk = K / 64;
  const int klast = K - 64;
  gemm_load<AMODE>(A, lda, s5, Bt, ldb, m0, n0, 0, lr, lk, ra0, ra1, ra2, ra3, rb0, rb1, rb2, rb3);
  __syncthreads();
  {
    u16* Aw = buf; u16* Bw = buf + BUFSZ;
    *(uint4*)(Aw + (lr)*LDT + lk) = ra0; *(uint4*)(Aw + (32 + lr) * LDT + lk) = ra1;
    *(uint4*)(Aw + (64 + lr) * LDT + lk) = ra2; *(uint4*)(Aw + (96 + lr) * LDT + lk) = ra3;
    *(uint4*)(Bw + (lr)*LDT + lk) = rb0; *(uint4*)(Bw + (32 + lr) * LDT + lk) = rb1;
    *(uint4*)(Bw + (64 + lr) * LDT + lk) = rb2; *(uint4*)(Bw + (96 + lr) * LDT + lk) = rb3;
  }
  gemm_load<AMODE>(A, lda, s5, Bt, ldb, m0, n0, (nk > 1) ? 64 : 0, lr, lk, ra0, ra1, ra2, ra3, rb0, rb1, rb2, rb3);
  __syncthreads();
  const int aoff = (wm * 64 + (lane & 15)) * LDT + (lane >> 4) * 8;
  const int boff = (wn * 64 + (lane & 15)) * LDT + (lane >> 4) * 8;
  for (int kt = 0; kt < nk; kt++) {
    const u16* Ar = buf + (kt & 1) * 2 * BUFSZ;
    const u16* Br = Ar + BUFSZ;
    u16* Aw = buf + ((kt & 1) ^ 1) * 2 * BUFSZ;
    u16* Bw = Aw + BUFSZ;
    bf16x8 af0[4], bf0[4], af1[4], bf1[4];
#pragma unroll
    for (int i = 0; i < 4; i++) af0[i] = *(const bf16x8*)(Ar + aoff + i * 16 * LDT);
#pragma unroll
    for (int j = 0; j < 4; j++) bf0[j] = *(const bf16x8*)(Br + boff + j * 16 * LDT);
    __builtin_amdgcn_sched_barrier(0);
#pragma unroll
    for (int i = 0; i < 2; i++)
#pragma unroll
      for (int j = 0; j < 4; j++) acc[i][j] = __builtin_amdgcn_mfma_f32_16x16x32_bf16(af0[i], bf0[j], acc[i][j], 0, 0, 0);
#pragma unroll
    for (int i = 0; i < 4; i++) af1[i] = *(const bf16x8*)(Ar + aoff + i * 16 * LDT + 32);
#pragma unroll
    for (int j = 0; j < 4; j++) bf1[j] = *(const bf16x8*)(Br + boff + j * 16 * LDT + 32);
    __builtin_amdgcn_sched_barrier(0);
#pragma unroll
    for (int i = 2; i < 4; i++)
#pragma unroll
      for (int j = 0; j < 4; j++) acc[i][j] = __builtin_amdgcn_mfma_f32_16x16x32_bf16(af0[i], bf0[j], acc[i][j], 0, 0, 0);
    *(uint4*)(Aw + (lr)*LDT + lk) = ra0; *(uint4*)(Aw + (32 + lr) * LDT + lk) = ra1;
    *(uint4*)(Aw + (64 + lr) * LDT + lk) = ra2; *(uint4*)(Aw + (96 + lr) * LDT + lk) = ra3;
    *(uint4*)(Bw + (lr)*LDT + lk) = rb0; *(uint4*)(Bw + (32 + lr) * LDT + lk) = rb1;
    *(uint4*)(Bw + (64 + lr) * LDT + lk) = rb2; *(uint4*)(Bw + (96 + lr) * LDT + lk) = rb3;
    __builtin_amdgcn_sched_barrier(0);
#pragma unroll
    for (int i = 0; i < 2; i++)
#pragma unroll
      for (int j = 0; j < 4; j++) acc[i][j] = __builtin_amdgcn_mfma_f32_16x16x32_bf16(af1[i], bf1[j], acc[i][j], 0, 0, 0);
    {
      int k2 = (kt + 2) * 64;
      k2 = (k2 > klast) ? klast : k2;
      gemm_load<AMODE>(A, lda, s5, Bt, ldb, m0, n0, k2, lr, lk, ra0, ra1, ra2, ra3, rb0, rb1, rb2, rb3);
    }
    __builtin_amdgcn_sched_barrier(0);
#pragma unroll
    for (int i = 2; i < 4; i++)
#pragma unroll
      for (int j = 0; j < 4; j++) acc[i][j] = __builtin_amdgcn_mfma_f32_16x16x32_bf16(af1[i], bf1[j], acc[i][j], 0, 0, 0);
    __syncthreads();
  }
}

#define TLD 132
__device__ __forceinline__ void stage_acc(const f32x4 (&acc)[4][4], float* T, int wm, int wn, int lane) {
#pragma unroll
  for (int i = 0; i < 4; i++)
#pragma unroll
    for (int j = 0; j < 4; j++)
#pragma unroll
      for (int r = 0; r < 4; r++) T[(wm * 64 + i * 16 + (lane >> 4) * 4 + r) * TLD + wn * 64 + j * 16 + (lane & 15)] = acc[i][j][r];
}
__device__ __forceinline__ uint4 pack8(const float4& a, const float4& b) {
  return make_uint4(pack2(a.x, a.y), pack2(a.z, a.w), pack2(b.x, b.y), pack2(b.z, b.w));
}

__device__ __forceinline__ void phase_inproj(const Params& p, int l, u16* sm, const Loc& lc) {
  const u16* H = (const u16*)(p.ws + OFF_HBUF);
  const u16* Wt = (const u16*)(p.ws + OFF_WINT) + (size_t)l * 2304 * HLD;
  u16* Qb = (u16*)(p.ws + OFF_QB);
  u16* Kb = (u16*)(p.ws + OFF_KB);
  u16* Vt = (u16*)(p.ws + OFF_VT);
  u16* Ub = (u16*)(p.ws + OFF_UB);
  u16* Zb = (u16*)(p.ws + OFF_ZB);
  const float* ropeC = (const float*)(p.ws + OFF_ROPE);
  const float* ropeS = ropeC + 1024;
  int tid = otid(), lane = tid & 63, w = tid >> 6, wm = w >> 1, wn = w & 1;
  S5Src dummy{};
  const int xq = lc.xq, lb = lc.lb, nl = lc.nl;
  for (int j = lb; j < 68 * 9; j += nl) {
    int mt = (xq >> 1) * 68 + j / 9, nt = (xq & 1) * 9 + j % 9;
    int m0 = mt * 128, n0 = nt * 128;
    if (l == 1 && (m0 % SB) < LCTX && (nt < 4 || nt >= 14)) continue;
    f32x4 acc[4][4];
#pragma unroll
    for (int i = 0; i < 4; i++)
#pragma unroll
      for (int j = 0; j < 4; j++) acc[i][j] = f32x4{0.f, 0.f, 0.f, 0.f};
    gemm_main<0>(H, HLD, dummy, Wt, HLD, DM, m0, n0, acc, sm, sm + 128 * LDT);
#ifdef PROBE_MAINLOOP2
    gemm_main<0>(H, HLD, dummy, Wt, HLD, DM, m0, n0, acc, sm, sm + 128 * LDT);
#pragma unroll
    for (int i = 0; i < 4; i++)
#pragma unroll
      for (int j = 0; j < 4; j++) acc[i][j] *= 0.5f;
#endif
    int b = m0 / SB, s0 = m0 - b * SB;
    bool is_ctx = s0 < LCTX;
    float* T = (float*)sm;
    if (nt >= 8 && nt < 12) {
      int f = lane & 15, qd = lane >> 4;
#pragma unroll
      for (int i = 0; i < 4; i++)
#pragma unroll
        for (int j = 0; j < 4; j++) {
          int dv = wn * 64 + j * 16 + f;
          int tk = wm * 64 + i * 16 + (((qd & 1) << 1) | (qd >> 1)) * 4;
          *(float4*)(T + dv * TLD + tk) = make_float4(acc[i][j][0], acc[i][j][1], acc[i][j][2], acc[i][j][3]);
        }
    } else {
      stage_acc(acc, T, wm, wn, lane);
    }
    __syncthreads();
    if (nt < 8) {
      int head = nt & 3;
      unsigned char* dstb = (unsigned char*)(nt < 4 ? Qb : Kb) + ((size_t)((b * 4 + head) * 2) * SB) * 64;
      float scale = (nt < 4) ? (0.125f * 1.4426950408889634f) : 1.f;
#pragma unroll
      for (int ps = 0; ps < 8; ps++) {
        int idx = ps * 256 + tid;
        int row = idx >> 4, c8 = (idx & 15) * 8;
        int map = c8 >> 6, d0 = c8 & 63;
        int s = s0 + row;
        float4 o0 = *(const float4*)(T + row * TLD + c8), o1 = *(const float4*)(T + row * TLD + c8 + 4);
        if (!is_ctx) {
          int pd = (d0 & 16) ? -16 : 16;
          float sgn = (d0 & 16) ? 1.f : -1.f;
          float4 p0 = *(const float4*)(T + row * TLD + c8 + pd), p1 = *(const float4*)(T + row * TLD + c8 + pd + 4);
          int t = s - LCTX;
          int pos = (d0 < 32) ? (t >> 6) : (t & 63);
          int f0 = d0 & 15;
          float4 c0 = *(const float4*)(ropeC + pos * 16 + f0), c1 = *(const float4*)(ropeC + pos * 16 + f0 + 4);
          float4 s0v = *(const float4*)(ropeS + pos * 16 + f0), s1v = *(const float4*)(ropeS + pos * 16 + f0 + 4);
          o0 = make_float4(o0.x * c0.x + sgn * p0.x * s0v.x, o0.y * c0.y + sgn * p0.y * s0v.y, o0.z * c0.z + sgn * p0.z * s0v.z, o0.w * c0.w + sgn * p0.w * s0v.w);
          o1 = make_float4(o1.x * c1.x + sgn * p1.x * s1v.x, o1.y * c1.y + sgn * p1.y * s1v.y, o1.z * c1.z + sgn * p1.z * s1v.z, o1.w * c1.w + sgn * p1.w * s1v.w);
        }
        o0 = make_float4(o0.x * scale, o0.y * scale, o0.z * scale, o0.w * scale);
        o1 = make_float4(o1.x * scale, o1.y * scale, o1.z * scale, o1.w * scale);
        int q0 = __builtin_amdgcn_cvt_pk_fp8_f32(o0.x, o0.y, 0, false); q0 = __builtin_amdgcn_cvt_pk_fp8_f32(o0.z, o0.w, q0, true);
        int q1 = __builtin_amdgcn_cvt_pk_fp8_f32(o1.x, o1.y, 0, false); q1 = __builtin_amdgcn_cvt_pk_fp8_f32(o1.z, o1.w, q1, true);
        *(uint2*)(dstb + ((size_t)map * SB + s) * 64 + d0) = make_uint2((unsigned)q0, (unsigned)q1);
      }
    } else if (nt < 12) {
      int head = nt - 8;
#pragma unroll
      for (int ps = 0; ps < 8; ps++) {
        int idx = ps * 256 + tid;
        int dv = idx >> 4, t8 = (idx & 15) * 8;
        float4 o0 = *(const float4*)(T + dv * TLD + t8), o1 = *(const float4*)(T + dv * TLD + t8 + 4);
        int q0 = __builtin_amdgcn_cvt_pk_fp8_f32(o0.x, o0.y, 0, false); q0 = __builtin_amdgcn_cvt_pk_fp8_f32(o0.z, o0.w, q0, true);
        int q1 = __builtin_amdgcn_cvt_pk_fp8_f32(o1.x, o1.y, 0, false); q1 = __builtin_amdgcn_cvt_pk_fp8_f32(o1.z, o1.w, q1, true);
        *(uint2*)((unsigned char*)Vt + ((size_t)((b * 4 + head) * 128 + dv)) * SB + s0 + t8) = make_uint2((unsigned)q0, (unsigned)q1);
      }
    } else {
      u16* dst; int ld, cbase;
      if (nt < 14) { dst = Ub; ld = 256; cbase = (nt - 12) * 128; }
      else { dst = Zb; ld = 512; cbase = (nt - 14) * 128; }
#pragma unroll
      for (int ps = 0; ps < 8; ps++) {
        int idx = ps * 256 + tid;
        int row = idx >> 4, c8 = (idx & 15) * 8;
        float4 o0 = *(const float4*)(T + row * TLD + c8), o1 = *(const float4*)(T + row * TLD + c8 + 4);
        *(uint4*)(dst + (size_t)(m0 + row) * ld + cbase + c8) = pack8(o0, o1);
      }
    }
  }
}

__device__ __forceinline__ void phase_s5g(const Params& p, int l, bool lat_only, int g_lo = 0, int g_hi = NT) {
  const u16* Ub = (const u16*)(p.ws + OFF_UB);
  const float* Yf = (const float*)(p.ws + OFF_YF);
  const float* Yb = (const float*)(p.ws + OFF_YB);
  const float* dsk = p.in[22] + (size_t)l * 256;
  u16* G = (u16*)(p.ws + OFF_G);
  int tid = otid();
  int c8 = (tid & 31) * 8;
  float4 d0 = *(const float4*)(dsk + c8), d1 = *(const float4*)(dsk + c8 + 4);
  int rstep = gridDim.x * 8;
  for (int g = g_lo + blockIdx.x * 8 + (tid >> 5); g < g_hi; g += rstep) {
    if (lat_only && (g % SB) < LCTX) continue;
    size_t o = (size_t)g * 256 + c8;
    uint4 u = *(const uint4*)(Ub + o);
    float4 a0 = *(const float4*)(Yf + o), a1 = *(const float4*)(Yf + o + 4);
    float4 b0 = *(const float4*)(Yb + o), b1 = *(const float4*)(Yb + o + 4);
    float y0 = gelu_tanh(d0.x * bflo(u.x) + a0.x + b0.x), y1 = gelu_tanh(d0.y * bfhi(u.x) + a0.y + b0.y);
    float y2 = gelu_tanh(d0.z * bflo(u.y) + a0.z + b0.z), y3 = gelu_tanh(d0.w * bfhi(u.y) + a0.w + b0.w);
    float y4 = gelu_tanh(d1.x * bflo(u.z) + a1.x + b1.x), y5 = gelu_tanh(d1.y * bfhi(u.z) + a1.y + b1.y);
    float y6 = gelu_tanh(d1.z * bflo(u.w) + a1.z + b1.z), y7 = gelu_tanh(d1.w * bfhi(u.w) + a1.w + b1.w);
    *(uint4*)(G + o) = make_uint4(pack2(y0, y1), pack2(y2, y3), pack2(y4, y5), pack2(y6, y7));
  }
}

__device__ __forceinline__ void phase_glu_pw(const Params& p, int l, bool lat_only, u16* sm) {
  u16* H = (u16*)(p.ws + OFF_HBUF);
  S5Src s5{(const u16*)(p.ws + OFF_UB), (const float*)(p.ws + OFF_YF), (const float*)(p.ws + OFF_YB), p.in[22] + (size_t)l * 256};
  const u16* Wg = (const u16*)(p.ws + OFF_WGLUT) + (size_t)l * 65536;
  const u16* Wp = (const u16*)(p.ws + OFF_WPWT) + (size_t)l * 65536;
  const u16* CV = (const u16*)(p.ws + OFF_CVIN);
  const u16* Gb = (const u16*)(p.ws + OFF_G);
  const float* bpw = p.in[29] + (size_t)l * 256;
  int tid = otid(), lane = tid & 63, w = tid >> 6, wm = w >> 1, wn = w & 1;
  int f = lane & 15;
  const int ntiles = (NT / 128) * 4;
  for (int it = blockIdx.x; it < ntiles; it += gridDim.x) {
    int mt = it >> 2, sub = it & 3;
    int m0 = mt * 128;
    int s0 = m0 % SB;
    if (lat_only && s0 < LCTX) continue;
    int n0 = (sub & 1) * 128;
    f32x4 acc[4][4];
#pragma unroll
    for (int i = 0; i < 4; i++)
#pragma unroll
      for (int j = 0; j < 4; j++) acc[i][j] = f32x4{0.f, 0.f, 0.f, 0.f};
    if (sub < 2) {
      gemm_main<0>(Gb, 256, s5, Wg, 256, 256, m0, n0, acc, sm, sm + 128 * LDT);
      float* T = (float*)sm;
      stage_acc(acc, T, wm, wn, lane);
      __syncthreads();
#pragma unroll
      for (int ps = 0; ps < 8; ps++) {
        int idx = ps * 256 + tid;
        int row = idx >> 4, c8 = (idx & 15) * 8;
        int g = m0 + row;
        float4 a0 = *(const float4*)(T + row * TLD + c8), a1 = *(const float4*)(T + row * TLD + c8 + 4);
        uint4 gg = *(const uint4*)(Gb + (size_t)g * 256 + n0 + c8);
        float4 o0 = make_float4(bflo(gg.x) * sigmoidf_(a0.x), bfhi(gg.x) * sigmoidf_(a0.y), bflo(gg.y) * sigmoidf_(a0.z), bfhi(gg.y) * sigmoidf_(a0.w));
        float4 o1 = make_float4(bflo(gg.z) * sigmoidf_(a1.x), bfhi(gg.z) * sigmoidf_(a1.y), bflo(gg.w) * sigmoidf_(a1.z), bfhi(gg.w) * sigmoidf_(a1.w));
        *(uint4*)(H + (size_t)g * HLD + 512 + n0 + c8) = pack8(o0, o1);
      }
    } else {
      gemm_main<0>(CV, 256, s5, Wp, 256, 256, m0, n0, acc, sm, sm + 128 * LDT);
      float* T = (float*)sm;
      stage_acc(acc, T, wm, wn, lane);
      __syncthreads();
#pragma unroll
      for (int ps = 0; ps < 8; ps++) {
        int idx = ps * 256 + tid;
        int row = idx >> 4, c8 = (idx & 15) * 8;
        int g = m0 + row;
        float4 a0 = *(const float4*)(T + row * TLD + c8), a1 = *(const float4*)(T + row * TLD + c8 + 4);
        float4 b0 = *(const float4*)(bpw + n0 + c8), b1 = *(const float4*)(bpw + n0 + c8 + 4);
        float4 o0 = make_float4(a0.x + b0.x, a0.y + b0.y, a0.z + b0.z, a0.w + b0.w);
        float4 o1 = make_float4(a1.x + b1.x, a1.y + b1.y, a1.z + b1.z, a1.w + b1.w);
        *(uint4*)(H + (size_t)g * HLD + 768 + n0 + c8) = pack8(o0, o1);
      }
    }
  }
}

__device__ __forceinline__ void phase_outproj(const Params& p, int l, bool lat_only, u16* sm, const Loc& lc) {
  const u16* H = (const u16*)(p.ws + OFF_HBUF);
  const u16* Wt = (const u16*)(p.ws + OFF_WOUTT) + (size_t)l * 1024 * HLD;
  int tid = otid(), lane = tid & 63, w = tid >> 6, wm = w >> 1, wn = w & 1;
  int f = lane & 15;
  S5Src dummy{};
  const int xq = lc.xq, lb = lc.lb, nl = lc.nl;
  for (int j = lb; j < 68 * 4; j += nl) {
    int mt = (xq >> 1) * 68 + (j >> 2), nt = (xq & 1) * 4 + (j & 3);
    int m0 = mt * 128, n0 = nt * 128;
    if (lat_only && (m0 % SB) < LCTX) continue;
    f32x4 acc[4][4];
#pragma unroll
    for (int i = 0; i < 4; i++)
#pragma unroll
      for (int j = 0; j < 4; j++) acc[i][j] = f32x4{0.f, 0.f, 0.f, 0.f};
    gemm_main<0>(H, HLD, dummy, Wt, HLD, DM, m0, n0, acc, sm, sm + 128 * LDT);
    const float* mv = mod_vec(p, l, m0) + 2048;
    float* T = (float*)sm;
    stage_acc(acc, T, wm, wn, lane);
    __syncthreads();
#pragma unroll
    for (int ps = 0; ps < 8; ps++) {
      int idx = ps * 256 + tid;
      int row = idx >> 4, c8 = (idx & 15) * 8;
      int g = m0 + row;
      const float* xs = res_src(p, l, g) + n0 + c8;
      float* xd = res_dst(p, g) + n0 + c8;
      float4 a0 = *(const float4*)(T + row * TLD + c8), a1 = *(const float4*)(T + row * TLD + c8 + 4);
      float4 x0 = *(const float4*)(xs), x1 = *(const float4*)(xs + 4);
      float4 g0 = *(const float4*)(mv + n0 + c8), g1 = *(const float4*)(mv + n0 + c8 + 4);
      *(float4*)(xd) = make_float4(x0.x + g0.x * a0.x, x0.y + g0.y * a0.y, x0.z + g0.z * a0.z, x0.w + g0.w * a0.w);
      *(float4*)(xd + 4) = make_float4(x1.x + g1.x * a1.x, x1.y + g1.y * a1.y, x1.z + g1.z * a1.z, x1.w + g1.w * a1.w);
    }
  }
}

#define CE_DESC(a, b) { float _hi = fmaxf(a, b); float _lo = fminf(a, b); a = _hi; b = _lo; }
__device__ __forceinline__ void sort16_desc(float (&v)[16]) {
#pragma unroll
  for (int k = 2; k <= 16; k <<= 1) {
#pragma unroll
    for (int j = k >> 1; j > 0; j >>= 1) {
#pragma unroll
      for (int i = 0; i < 16; i++) {
        int l = i ^ j;
        if (l > i) {
          if ((i & k) == 0) { CE_DESC(v[i], v[l]) } else { CE_DESC(v[l], v[i]) }
        }
      }
    }
  }
}
__device__ __forceinline__ void merge16_desc(float (&a)[16], const float (&b)[16]) {
#pragma unroll
  for (int i = 0; i < 16; i++) a[i] = fmaxf(a[i], b[15 - i]);
#pragma unroll
  for (int j = 8; j > 0; j >>= 1) {
#pragma unroll
    for (int i = 0; i < 16; i++) {
      if ((i & j) == 0) { CE_DESC(a[i], a[i + j]) }
    }
  }
}

__device__ __forceinline__ void phase_peerq(const Params& p, int l, bool lat_only, u16* sm, const Loc& lc) {
  const u16* H = (const u16*)(p.ws + OFF_HBUF);
  const u16* Wt = (const u16*)(p.ws + OFF_WQT) + (size_t)l * 2048 * HLD;
  const u16* SK = (const u16*)(p.ws + OFF_SUBK) + (size_t)l * 8 * 2 * 128 * 128;
  float* TK = (float*)(p.ws + OFF_QB);
  int tid = otid(), lane = tid & 63, w = tid >> 6, wm = w >> 1, wn = w & 1;
  int f = lane & 15;
  S5Src dummy{};
  const int xq = lc.xq, lb = lc.lb, nl = lc.nl;
  for (int j = lb; j < 136 * 4; j += nl) {
    int mt = (xq >> 2) * 136 + (j >> 2), hm = (xq & 3) * 4 + (j & 3);
    int m0 = mt * 128, n0 = hm * 128;
    if (lat_only && (m0 % SB) < LCTX) continue;
    f32x4 acc[4][4];
#pragma unroll
    for (int i = 0; i < 4; i++)
#pragma unroll
      for (int j = 0; j < 4; j++) acc[i][j] = f32x4{0.f, 0.f, 0.f, 0.f};
    gemm_main<0>(H, HLD, dummy, Wt, HLD, DM, m0, n0, acc, sm, sm + 128 * LDT);
    __syncthreads();
    u16* Qs = sm;
    u16* Ss = sm + 128 * 136;
#pragma unroll
    for (int i = 0; i < 4; i++)
#pragma unroll
      for (int j = 0; j < 4; j++)
#pragma unroll
        for (int r = 0; r < 4; r++) {
          int row = wm * 64 + i * 16 + (lane >> 4) * 4 + r;
          Qs[row * 136 + wn * 64 + j * 16 + f] = f2bf(acc[i][j][r]);
        }
    {
      const u16* src = SK + (size_t)hm * 128 * 128;
#pragma unroll
      for (int ps = 0; ps < 8; ps++) {
        int idx = ps * 256 + tid;
        int row = idx >> 4, seg = (idx & 15) * 8;
        *(uint4*)(Ss + row * 136 + seg) = *(const uint4*)(src + row * 128 + seg);
      }
    }
    __syncthreads();
#pragma unroll
    for (int i = 0; i < 4; i++)
#pragma unroll
      for (int j = 0; j < 4; j++) acc[i][j] = f32x4{0.f, 0.f, 0.f, 0.f};
#pragma unroll
    for (int kk = 0; kk < 4; kk++) mma_step(Qs, 136, Ss, 136, kk * 32, wm, wn, lane, acc);
    __syncthreads();
    float* Sc = (float*)sm;
    float* Lm = (float*)sm + 128 * 132;
#pragma unroll
    for (int i = 0; i < 4; i++)
#pragma unroll
      for (int j = 0; j < 4; j++)
#pragma unroll
        for (int r = 0; r < 4; r++) {
          int row = wm * 64 + i * 16 + (lane >> 4) * 4 + r;
          Sc[row * 132 + wn * 64 + j * 16 + f] = acc[i][j][r];
        }
    __syncthreads();
    int row = tid >> 1, half = tid & 1;
    float top[16];
    {
      float g1[16], g2[16], g3[16];
#pragma unroll
      for (int q = 0; q < 4; q++) {
        float4 x4 = *(const float4*)(Sc + row * 132 + half * 64 + q * 4);
        float4 y4 = *(const float4*)(Sc + row * 132 + half * 64 + 16 + q * 4);
        float4 z4 = *(const float4*)(Sc + row * 132 + half * 64 + 32 + q * 4);
        float4 w4 = *(const float4*)(Sc + row * 132 + half * 64 + 48 + q * 4);
        uint32_t kb = (uint32_t)(half * 64 + q * 4);
        top[q * 4 + 0] = __uint_as_float((__float_as_uint(x4.x) & ~127u) | (kb + 0)); top[q * 4 + 1] = __uint_as_float((__float_as_uint(x4.y) & ~127u) | (kb + 1));
        top[q * 4 + 2] = __uint_as_float((__float_as_uint(x4.z) & ~127u) | (kb + 2)); top[q * 4 + 3] = __uint_as_float((__float_as_uint(x4.w) & ~127u) | (kb + 3));
        g1[q * 4 + 0] = __uint_as_float((__float_as_uint(y4.x) & ~127u) | (kb + 16)); g1[q * 4 + 1] = __uint_as_float((__float_as_uint(y4.y) & ~127u) | (kb + 17));
        g1[q * 4 + 2] = __uint_as_float((__float_as_uint(y4.z) & ~127u) | (kb + 18)); g1[q * 4 + 3] = __uint_as_float((__float_as_uint(y4.w) & ~127u) | (kb + 19));
        g2[q * 4 + 0] = __uint_as_float((__float_as_uint(z4.x) & ~127u) | (kb + 32)); g2[q * 4 + 1] = __uint_as_float((__float_as_uint(z4.y) & ~127u) | (kb + 33));
        g2[q * 4 + 2] = __uint_as_float((__float_as_uint(z4.z) & ~127u) | (kb + 34)); g2[q * 4 + 3] = __uint_as_float((__float_as_uint(z4.w) & ~127u) | (kb + 35));
        g3[q * 4 + 0] = __uint_as_float((__float_as_uint(w4.x) & ~127u) | (kb + 48)); g3[q * 4 + 1] = __uint_as_float((__float_as_uint(w4.y) & ~127u) | (kb + 49));
        g3[q * 4 + 2] = __uint_as_float((__float_as_uint(w4.z) & ~127u) | (kb + 50)); g3[q * 4 + 3] = __uint_as_float((__float_as_uint(w4.w) & ~127u) | (kb + 51));
      }
      sort16_desc(top); sort16_desc(g1); sort16_desc(g2); sort16_desc(g3);
      merge16_desc(top, g1);
      merge16_desc(g2, g3);
      merge16_desc(top, g2);
    }
    if (half == 1) {
#pragma unroll
      for (int q = 0; q < 4; q++) *(float4*)(Lm + row * 16 + q * 4) = make_float4(top[q * 4], top[q * 4 + 1], top[q * 4 + 2], top[q * 4 + 3]);
    }
    __syncthreads();
    if (half == 0) {
      float o[16];
#pragma unroll
      for (int q = 0; q < 4; q++) {
        float4 t4 = *(const float4*)(Lm + row * 16 + q * 4);
        o[q * 4] = t4.x; o[q * 4 + 1] = t4.y; o[q * 4 + 2] = t4.z; o[q * 4 + 3] = t4.w;
      }
      merge16_desc(top, o);
      float4* d = (float4*)(TK + ((size_t)(m0 + row) * 16 + hm) * 16);
      d[0] = make_float4(top[0], top[1], top[2], top[3]);
      d[1] = make_float4(top[4], top[5], top[6], top[7]);
      d[2] = make_float4(top[8], top[9], top[10], top[11]);
      d[3] = make_float4(top[12], top[13], top[14], top[15]);
    }
    __syncthreads();
  }
}

__device__ __forceinline__ void attn_item(const Params& p, int l, int item, char* smc) {
  int b = item / (4 * 68), rem = item % (4 * 68);
  int h = rem / 68, qb = rem % 68;
  int nkeys = (qb < 4) ? LCTX : SB;
  int s0 = qb * 64;
  int tid = otid(), lane = tid & 63, w = tid >> 6;
  int m = w & 1, qg = w >> 1;
  int r = lane & 31, hh = lane >> 5;
  u16* sm = (u16*)smc;
  unsigned char* Ks = (unsigned char*)smc;
  unsigned char* Vs = (unsigned char*)smc + 2 * 128 * 80;
  unsigned char* Qs = (unsigned char*)smc + 2 * 128 * 80 + 128 * 144;
  float* X = (float*)smc;
  const unsigned char* Qg = (const unsigned char*)(p.ws + OFF_QB) + ((size_t)(b * 4 + h) * 2) * SB * 64;
  const unsigned char* Kg = (const unsigned char*)(p.ws + OFF_KB) + ((size_t)(b * 4 + h) * 2) * SB * 64;
  const unsigned char* Vg = (const unsigned char*)(p.ws + OFF_VT) + ((size_t)(b * 4 + h) * 128) * SB;
  float lam_init = 0.8f - 0.6f * expf(-0.3f * (float)l);
  float lam;
  {
    int oz = opaque_zero();
    float a = p.in[10][l * 64 + lane + oz] * p.in[11][l * 64 + lane + oz];
    float c = p.in[12][l * 64 + lane + oz] * p.in[13][l * 64 + lane + oz];
    a = wave_sum(a); c = wave_sum(c);
    lam = expf(a) - expf(c) + lam_init;
  }
  __syncthreads();
#pragma unroll
  for (int ps = 0; ps < 2; ps++) {
    int idx = ps * 256 + tid;
    int mm = idx >> 8, row = (idx >> 2) & 63, seg = (idx & 3) * 16;
    *(uint4*)(Qs + (mm * 64 + row) * 80 + seg) = *(const uint4*)(Qg + ((size_t)mm * SB + s0 + row) * 64 + seg);
  }
  __syncthreads();
  long qfr[4];
#pragma unroll
  for (int ks = 0; ks < 4; ks++) qfr[ks] = *(const long*)(Qs + (m * 64 + qg * 32 + r) * 80 + ks * 16 + hh * 8);
  f32x16 O[4];
#pragma unroll
  for (int dt = 0; dt < 4; dt++)
#pragma unroll
    for (int i = 0; i < 16; i++) O[dt][i] = 0.f;
  float mrun = 0.f, lrun = 0.f;
  const int st_seg = (tid & 3) * 16;
  const int st_row = tid >> 2;
  const int sv_seg = (tid & 7) * 16;
  const int sv_row = tid >> 3;
  const int nstep = nkeys >> 7;
  uint4 kr0, kr1, kr2, kr3, vr0, vr1, vr2, vr3;
#define ATT_LOADK(KN)                                                                   \
  kr0 = *(const uint4*)(Kg + ((size_t)0 * SB + (KN) + st_row) * 64 + st_seg);           \
  kr1 = *(const uint4*)(Kg + ((size_t)0 * SB + (KN) + 64 + st_row) * 64 + st_seg);      \
  kr2 = *(const uint4*)(Kg + ((size_t)1 * SB + (KN) + st_row) * 64 + st_seg);           \
  kr3 = *(const uint4*)(Kg + ((size_t)1 * SB + (KN) + 64 + st_row) * 64 + st_seg);
#define ATT_LOADV(KN)                                                                   \
  vr0 = *(const uint4*)(Vg + (size_t)(sv_row)*SB + (KN) + sv_seg);                      \
  vr1 = *(const uint4*)(Vg + (size_t)(32 + sv_row) * SB + (KN) + sv_seg);               \
  vr2 = *(const uint4*)(Vg + (size_t)(64 + sv_row) * SB + (KN) + sv_seg);               \
  vr3 = *(const uint4*)(Vg + (size_t)(96 + sv_row) * SB + (KN) + sv_seg);
#define ATT_WRITEK()                                                                    \
  *(uint4*)(Ks + (0 * 128 + st_row) * 80 + st_seg) = kr0;                               \
  *(uint4*)(Ks + (0 * 128 + 64 + st_row) * 80 + st_seg) = kr1;                          \
  *(uint4*)(Ks + (1 * 128 + st_row) * 80 + st_seg) = kr2;                               \
  *(uint4*)(Ks + (1 * 128 + 64 + st_row) * 80 + st_seg) = kr3;
#define ATT_WRITEV()                                                                    \
  *(uint4*)(Vs + (sv_row)*144 + sv_seg) = vr0;                                          \
  *(uint4*)(Vs + (32 + sv_row) * 144 + sv_seg) = vr1;                                   \
  *(uint4*)(Vs + (64 + sv_row) * 144 + sv_seg) = vr2;                                   \
  *(uint4*)(Vs + (96 + sv_row) * 144 + sv_seg) = vr3;
  ATT_LOADK(0)
  ATT_LOADV(0)
  for (int t = 0; t < nstep; t++) {
    __syncthreads();
    ATT_WRITEK()
    ATT_WRITEV()
    __syncthreads();
    if (t + 1 < nstep) { int kn = (t + 1) * 128; ATT_LOADK(kn) ATT_LOADV(kn) }
    __builtin_amdgcn_sched_barrier(0);
#pragma unroll
    for (int sub = 0; sub < 2; sub++) {
      const bool first = (sub == 0) && (t == 0);
      f32x16 sa, sb;
      {
        float ninit = first ? 0.f : -mrun;
#pragma unroll
        for (int i = 0; i < 16; i++) { sa[i] = ninit; sb[i] = ninit; }
      }
#pragma unroll
      for (int ks = 0; ks < 4; ks++) {
        long k0f = *(const long*)(Ks + (m * 128 + sub * 64 + r) * 80 + ks * 16 + hh * 8);
        long k1f = *(const long*)(Ks + (m * 128 + sub * 64 + 32 + r) * 80 + ks * 16 + hh * 8);
        sa = __builtin_amdgcn_mfma_f32_32x32x16_fp8_fp8(k0f, qfr[ks], sa, 0, 0, 0);
        sb = __builtin_amdgcn_mfma_f32_32x32x16_fp8_fp8(k1f, qfr[ks], sb, 0, 0, 0);
      }
      float mx = sa[0];
#pragma unroll
      for (int i = 1; i < 16; i++) mx = fmaxf(mx, sa[i]);
#pragma unroll
      for (int i = 0; i < 16; i++) mx = fmaxf(mx, sb[i]);
      {
        auto pr_ = __builtin_amdgcn_permlane32_swap(__float_as_uint(mx), __float_as_uint(mx), false, false);
        mx = fmaxf(__uint_as_float(pr_[0]), __uint_as_float(pr_[1]));
      }
      if (first) {
        mrun = mx;
#pragma unroll
        for (int i = 0; i < 16; i++) { sa[i] -= mx; sb[i] -= mx; }
      } else if (__any(mx > 8.f)) {
        float dlt = fmaxf(mx, 0.f);
        float alpha = __builtin_amdgcn_exp2f(-dlt);
        mrun += dlt;
        lrun *= alpha;
#pragma unroll
        for (int i = 0; i < 16; i++) { sa[i] -= dlt; sb[i] -= dlt; }
#pragma unroll
        for (int dt = 0; dt < 4; dt++)
#pragma unroll
          for (int i = 0; i < 16; i++) O[dt][i] *= alpha;
      }
      float ls = 0.f;
#pragma unroll
      for (int i = 0; i < 16; i++) { sa[i] = __builtin_amdgcn_exp2f(sa[i]); ls += sa[i]; }
#pragma unroll
      for (int i = 0; i < 16; i++) { sb[i] = __builtin_amdgcn_exp2f(sb[i]); ls += sb[i]; }
      lrun += ls;
      long pf[2][2];
#pragma unroll
      for (int s = 0; s < 2; s++) {
        int a0_ = __builtin_amdgcn_cvt_pk_fp8_f32(sa[8 * s + 0], sa[8 * s + 1], 0, false); a0_ = __builtin_amdgcn_cvt_pk_fp8_f32(sa[8 * s + 2], sa[8 * s + 3], a0_, true);
        int a1_ = __builtin_amdgcn_cvt_pk_fp8_f32(sa[8 * s + 4], sa[8 * s + 5], 0, false); a1_ = __builtin_amdgcn_cvt_pk_fp8_f32(sa[8 * s + 6], sa[8 * s + 7], a1_, true);
        int b0_ = __builtin_amdgcn_cvt_pk_fp8_f32(sb[8 * s + 0], sb[8 * s + 1], 0, false); b0_ = __builtin_amdgcn_cvt_pk_fp8_f32(sb[8 * s + 2], sb[8 * s + 3], b0_, true);
        int b1_ = __builtin_amdgcn_cvt_pk_fp8_f32(sb[8 * s + 4], sb[8 * s + 5], 0, false); b1_ = __builtin_amdgcn_cvt_pk_fp8_f32(sb[8 * s + 6], sb[8 * s + 7], b1_, true);
        pf[0][s] = (long)(((unsigned long)(unsigned)a1_ << 32) | (unsigned long)(unsigned)a0_);
        pf[1][s] = (long)(((unsigned long)(unsigned)b1_ << 32) | (unsigned long)(unsigned)b0_);
      }
#pragma unroll
      for (int kt = 0; kt < 2; kt++)
#pragma unroll
        for (int s = 0; s < 2; s++)
#pragma unroll
          for (int dt = 0; dt < 4; dt++) {
            long vf = *(const long*)(Vs + (dt * 32 + r) * 144 + sub * 64 + kt * 32 + s * 16 + hh * 8);
            O[dt] = __builtin_amdgcn_mfma_f32_32x32x16_fp8_fp8(vf, pf[kt][s], O[dt], 0, 0, 0);
          }
    }
  }
#undef ATT_LOADK
#undef ATT_LOADV
#undef ATT_WRITEK
#undef ATT_WRITEV
  float ltot = lrun + __shfl_xor(lrun, 32);
  __syncthreads();
  if (m == 1) {
    float sc = lam / ltot;
#pragma unroll
    for (int dt = 0; dt < 4; dt++)
#pragma unroll
      for (int i = 0; i < 16; i++) X[(qg * 64 + dt * 16 + i) * 64 + lane] = O[dt][i] * sc;
  }
  __syncthreads();
  if (m == 0) {
    float i0 = 1.f / ltot;
    float ss = 0.f;
#pragma unroll
    for (int dt = 0; dt < 4; dt++)
#pragma unroll
      for (int i = 0; i < 16; i++) {
        float o = O[dt][i] * i0 - X[(qg * 64 + dt * 16 + i) * 64 + lane];
        O[dt][i] = o;
        ss += o * o;
      }
    ss += __shfl_xor(ss, 32);
    float rr = rsqrtf(ss * (1.f / 128.f) + 1e-6f) * (1.f - lam_init);
    const float* sg = p.in[14] + (size_t)l * 128 + opaque_zero();
    int g = b * SB + s0 + qg * 32 + r;
    u16* dst = (u16*)(p.ws + OFF_HBUF) + (size_t)g * HLD + h * 128;
#pragma unroll
    for (int dt = 0; dt < 4; dt++)
#pragma unroll
      for (int q4 = 0; q4 < 4; q4++) {
        int dv = dt * 32 + 8 * q4 + 4 * hh;
        float4 gg = *(const float4*)(sg + dv);
        *(uint2*)(dst + dv) = make_uint2(pack2(O[dt][q4 * 4 + 0] * rr * gg.x, O[dt][q4 * 4 + 1] * rr * gg.y),
                                         pack2(O[dt][q4 * 4 + 2] * rr * gg.z, O[dt][q4 * 4 + 3] * rr * gg.w));
      }
  }
}

__device__ __forceinline__ void s5_item(const Params& p, int l, int item, float* sm) {
  int b = item >> 5, dir = (item >> 4) & 1, g = item & 15;
  int pidx = ((l * 2 + dir) * 16 + g) * 64;
  const float* Aw = (const float*)(p.ws + OFF_S5A);
  const float* BB = (const float*)(p.ws + OFF_S5BB);
  const float* cre = p.in[20] + (size_t)((l * 2 + dir) * 16 + g) * 16 * 64;
  const float* cim = p.in[21] + (size_t)((l * 2 + dir) * 16 + g) * 16 * 64;
  const u16* Ub = (const u16*)(p.ws + OFF_UB);
  float* Y = (float*)(p.ws + (dir ? OFF_YB : OFF_YF));
  float* Hr = sm;
  float* Hi = sm + 4352;
  float* Er = sm + 8704;
  float* Ei = Er + 256;
  float* Cc = Er + 512;
  u16* Hb = (u16*)(sm + 8704 + 768);
  int tid = otid(), lane = tid & 63, w = tid >> 6;
  int pp = tid & 63, sub = w;
  int r = lane & 31, hh = lane >> 5;
  float a_r = Aw[pidx + pp], a_i = Aw[4096 + pidx + pp];
  float a16r = a_r, a16i = a_i;
#pragma unroll
  for (int k = 0; k < 4; k++) { float nr = a16r * a16r - a16i * a16i; float ni = 2.f * a16r * a16i; a16r = nr; a16i = ni; }
  bf16x8 bfrag;
  {
    const float* s = BB + (w >= 2 ? 65536 : 0) + (size_t)(pidx + (w & 1) * 32 + r) * 16 + 8 * hh;
    float4 x0 = *(const float4*)s, x1 = *(const float4*)(s + 4);
    uint4 u = make_uint4(pack2(x0.x, x0.y), pack2(x0.z, x0.w), pack2(x1.x, x1.y), pack2(x1.z, x1.w));
    bfrag = __builtin_bit_cast(bf16x8, u);
  }
  bf16x8 cf[4];
  {
    int hcol = lane & 15, kq = lane >> 4;
#pragma unroll
    for (int ks = 0; ks < 4; ks++) {
      int kb = ks * 32 + kq * 8;
      const float* s = (kb < 64) ? (cre + hcol * 64 + kb) : (cim + hcol * 64 + kb - 64);
      float sg = (kb < 64) ? 1.f : -1.f;
      float4 x0 = *(const float4*)s, x1 = *(const float4*)(s + 4);
      uint4 u = make_uint4(pack2(sg * x0.x, sg * x0.y), pack2(sg * x0.z, sg * x0.w), pack2(sg * x1.x, sg * x1.y), pack2(sg * x1.z, sg * x1.w));
      cf[ks] = __builtin_bit_cast(bf16x8, u);
    }
  }
  __syncthreads();
  if (tid < 128) Cc[tid] = 0.f;
  const int sstep = (dir == 0) ? 1 : -1;
  uint4 ua0, ua1;
  {
    int sbase = (dir == 0) ? 0 : 255;
    ua0 = *(const uint4*)(Ub + ((size_t)(b * SB + sbase + sstep * r)) * 256 + g * 16 + 8 * hh);
    ua1 = *(const uint4*)(Ub + ((size_t)(b * SB + sbase + sstep * (32 + r))) * 256 + g * 16 + 8 * hh);
  }
  for (int c = 0; c < 68; c++) {
    int i0 = c * 64;
    int sbase = (dir == 0) ? i0 : (i0 < 256 ? 255 - i0 : 4607 - i0);
    {
      f32x16 z;
#pragma unroll
      for (int i = 0; i < 16; i++) z[i] = 0.f;
      f32x16 d0 = __builtin_amdgcn_mfma_f32_32x32x16_bf16(__builtin_bit_cast(bf16x8, ua0), bfrag, z, 0, 0, 0);
      f32x16 d1 = __builtin_amdgcn_mfma_f32_32x32x16_bf16(__builtin_bit_cast(bf16x8, ua1), bfrag, z, 0, 0, 0);
      float* Hx = (w >= 2) ? Hi : Hr;
      int pcol = (w & 1) * 32 + r;
#pragma unroll
      for (int i = 0; i < 16; i++) {
        int row = (i & 3) + 8 * (i >> 2) + 4 * hh;
        Hx[row * 68 + pcol] = d0[i];
        Hx[(32 + row) * 68 + pcol] = d1[i];
      }
    }
    if (c + 1 < 68) {
      int i1 = i0 + 64;
      int sb1 = (dir == 0) ? i1 : (i1 < 256 ? 255 - i1 : 4607 - i1);
      ua0 = *(const uint4*)(Ub + ((size_t)(b * SB + sb1 + sstep * r)) * 256 + g * 16 + 8 * hh);
      ua1 = *(const uint4*)(Ub + ((size_t)(b * SB + sb1 + sstep * (32 + r))) * 256 + g * 16 + 8 * hh);
    }
    __syncthreads();
    float lr[16], li[16];
    {
      float er = 0.f, ei = 0.f;
#pragma unroll
      for (int t = 0; t < 16; t++) {
        float xr = Hr[(sub * 16 + t) * 68 + pp], xi = Hi[(sub * 16 + t) * 68 + pp];
        float nr = a_r * er - a_i * ei + xr;
        float ni = a_r * ei + a_i * er + xi;
        er = nr; ei = ni;
        lr[t] = er; li[t] = ei;
      }
      Er[sub * 64 + pp] = er; Ei[sub * 64 + pp] = ei;
    }
    __syncthreads();
    {
      float sr = Cc[(c & 1) * 128 + pp], si = Cc[(c & 1) * 128 + 64 + pp];
      for (int j = 0; j < sub; j++) {
        float e_r = Er[j * 64 + pp], e_i = Ei[j * 64 + pp];
        float nr = a16r * sr - a16i * si + e_r;
        float ni = a16r * si + a16i * sr + e_i;
        sr = nr; si = ni;
      }
      float pr = a_r, pi = a_i;
      float last_r = 0.f, last_i = 0.f;
#pragma unroll
      for (int t = 0; t < 16; t++) {
        float hr = lr[t] + pr * sr - pi * si;
        float hi = li[t] + pr * si + pi * sr;
        Hb[(sub * 16 + t) * 136 + pp] = f2bf(hr);
        Hb[(sub * 16 + t) * 136 + 64 + pp] = f2bf(hi);
        last_r = hr; last_i = hi;
        float npr = pr * a_r - pi * a_i;
        float npi = pr * a_i + pi * a_r;
        pr = npr; pi = npi;
      }
      if (sub == 3) { Cc[((c + 1) & 1) * 128 + pp] = last_r; Cc[((c + 1) & 1) * 128 + 64 + pp] = last_i; }
    }
    {
      f32x4 acc = f32x4{0.f, 0.f, 0.f, 0.f};
#pragma unroll
      for (int ks = 0; ks < 4; ks++) {
        bf16x8 af = *(const bf16x8*)(Hb + (w * 16 + (lane & 15)) * 136 + ks * 32 + (lane >> 4) * 8);
        acc = __builtin_amdgcn_mfma_f32_16x16x32_bf16(af, cf[ks], acc, 0, 0, 0);
      }
#pragma unroll
      for (int rr = 0; rr < 4; rr++) {
        int tok = w * 16 + (lane >> 4) * 4 + rr;
        int s = sbase + sstep * tok;
        Y[((size_t)(b * SB + s)) * 256 + g * 16 + (lane & 15)] = acc[rr];
      }
    }
  }
}

__device__ __forceinline__ void conv_item(const Params& p, int l, int item, char* smc) {
  int g0 = item * 32;
  int b = g0 / SB, s0 = g0 - b * SB;
  int seg_lo = (s0 < LCTX) ? 0 : LCTX, seg_hi = (s0 < LCTX) ? LCTX : SB;
  const u16* Zb = (const u16*)(p.ws + OFF_ZB);
  u16* hg = (u16*)smc;
  float* co = (float*)(smc + 62 * 256 * 2);
  int tid = otid(), lane = tid & 63, w = tid >> 6;
  __syncthreads();
  for (int idx = tid; idx < 62 * 32; idx += NTHREADS) {
    int rr = idx >> 5, c8 = (idx & 31) * 8;
    int s = s0 - 15 + rr;
    uint4 o = make_uint4(0, 0, 0, 0);
    if (s >= seg_lo && s < seg_hi) {
      const u16* zr = Zb + ((size_t)(b * SB + s)) * 512;
      uint4 a = *(const uint4*)(zr + c8), gt = *(const uint4*)(zr + 256 + c8);
      o.x = pack2(bflo(a.x) * sigmoidf_(bflo(gt.x)), bfhi(a.x) * sigmoidf_(bfhi(gt.x)));
      o.y = pack2(bflo(a.y) * sigmoidf_(bflo(gt.y)), bfhi(a.y) * sigmoidf_(bfhi(gt.y)));
      o.z = pack2(bflo(a.z) * sigmoidf_(bflo(gt.z)), bfhi(a.z) * sigmoidf_(bfhi(gt.z)));
      o.w = pack2(bflo(a.w) * sigmoidf_(bflo(gt.w)), bfhi(a.w) * sigmoidf_(bfhi(gt.w)));
    }
    *(uint4*)(hg + rr * 256 + c8) = o;
  }
  __syncthreads();
  {
    int c = tid;
    const float* wd = p.in[24] + (size_t)l * 31 * 256 + opaque_zero();
    float wv[31];
#pragma unroll
    for (int j = 0; j < 31; j++) wv[j] = wd[j * 256 + c];
    float bd = p.in[25][l * 256 + c + opaque_zero()];
#pragma unroll 2
    for (int t = 0; t < 32; t++) {
      float acc = bd;
#pragma unroll
      for (int j = 0; j < 31; j++) acc += wv[j] * bf2f(hg[(t + j) * 256 + c]);
      co[t * 256 + c] = acc;
    }
  }
  __syncthreads();
  {
    const float* lg = p.in[26] + (size_t)l * 256 + opaque_zero();
    const float* lb = p.in[27] + (size_t)l * 256 + opaque_zero();
    float4 gg = *(const float4*)(lg + lane * 4), bb = *(const float4*)(lb + lane * 4);
    u16* CV = (u16*)(p.ws + OFF_CVIN);
    for (int tt = 0; tt < 8; tt++) {
      int t = w * 8 + tt;
      float4 v = *(const float4*)(co + t * 256 + lane * 4);
      float sm1 = v.x + v.y + v.z + v.w;
      sm1 = wave_sum(sm1);
      float mean = sm1 * (1.f / 256.f);
      float d0 = v.x - mean, d1 = v.y - mean, d2 = v.z - mean, d3 = v.w - mean;
      float sq = d0 * d0 + d1 * d1 + d2 * d2 + d3 * d3;
      sq = wave_sum(sq);
      float rstd = rsqrtf(sq * (1.f / 256.f) + 1e-6f);
      float y0 = siluf_(d0 * rstd * gg.x + bb.x), y1 = siluf_(d1 * rstd * gg.y + bb.y);
      float y2 = siluf_(d2 * rstd * gg.z + bb.z), y3 = siluf_(d3 * rstd * gg.w + bb.w);
      *(uint2*)(CV + ((size_t)(g0 + t)) * 256 + lane * 4) = make_uint2(pack2(y0, y1), pack2(y2, y3));
    }
  }
}

__device__ __forceinline__ void phase_mix(const Params& p, int l, bool lat_only, char* smc, int cidx, const Loc& lc, int mode = 0) {
  int* cnt = (int*)(p.ws + OFF_CNT) + cidx * 16;
  int* slot = (int*)(smc + SMEM_BYTES - 16);
  const int N_S5 = 256, N_CV = NT / 32;
  if (mode != 1) {
    while (true) {
      __syncthreads();
      if (otid() == 0) *slot = atomicAdd(cnt, 1);
      __syncthreads();
      int item = *slot;
      if (item >= N_S5) break;
      s5_item(p, l, item, (float*)smc);
      asm volatile("s_waitcnt vmcnt(0)" ::: "memory");
      __syncthreads();
      if (otid() == 0) {
        __builtin_amdgcn_fence(__ATOMIC_RELEASE, "agent");
        asm volatile("s_waitcnt vmcnt(0)" ::: "memory");
        __hip_atomic_fetch_add((int*)(p.ws + OFF_BAR + 15400) + l * 8 + (item >> 5), 1, __ATOMIC_RELAXED, __HIP_MEMORY_SCOPE_AGENT);
      }
    }
  }
  if (mode != 2) {
    int xcd = lc.xq;
    for (int rot = 0; rot < 8; rot++) {
      int xq = (xcd + rot) & 7;
      while (true) {
        __syncthreads();
        if (otid() == 0) *slot = atomicAdd(cnt + 1 + xq, 1);
        __syncthreads();
        int j = *slot;
        if (j >= 4 * 68) break;
        int pair = xq + 8 * (j / 68), qb = j % 68;
        if (lat_only && qb < 4) continue;
        attn_item(p, l, pair * 68 + qb, smc);
      }
    }
  }
  if (mode != 1) {
    while (true) {
      __syncthreads();
      if (otid() == 0) *slot = atomicAdd(cnt + 9, 1);
      __syncthreads();
      int item = *slot;
      if (item >= N_CV) break;
      if (lat_only && ((item * 32) % SB) < LCTX) continue;
      conv_item(p, l, item, smc);
    }
  }
  if (mode == 0) {
    for (int b = 0; b < NB; b++) {
      __syncthreads();
      if (otid() == 0) {
        int* c = (int*)(p.ws + OFF_BAR + 15400) + l * 8 + b;
        unsigned sp = 0;
        while (__hip_atomic_load(c, __ATOMIC_RELAXED, __HIP_MEMORY_SCOPE_AGENT) < 32) {
          __builtin_amdgcn_s_sleep(2);
          if (++sp > (1u << 22)) break;
        }
        __builtin_amdgcn_fence(__ATOMIC_ACQUIRE, "agent");
        asm volatile("s_waitcnt vmcnt(0)" ::: "memory");
      }
      __syncthreads();
      phase_s5g(p, l, lat_only, b * SB, (b + 1) * SB);
    }
  }
}

__device__ __forceinline__ void phase_gather(const Params& p, int l, bool last, char* smc, bool dry = false) {
  int tid = otid(), lane = tid & 63, w = tid >> 6;
  float* selv = (float*)smc + w * 512;
  int* seli = (int*)smc + w * 512 + 128;
  float* selu = (float*)smc + w * 512 + 256;
  const u16* H = (const u16*)(p.ws + OFF_HBUF);
  const float* TK = (const float*)(p.ws + OFF_QB);
  const unsigned char* UT = (const unsigned char*)(p.ws + OFF_UTAB) + (size_t)l * 16384 * 1024;
  const unsigned char* VT = (const unsigned char*)(p.ws + OFF_VTAB) + (size_t)l * 16384 * V_ROWB;
  const float* USC = (const float*)(p.ws + OFF_USC) + (size_t)l * 16384;
  const float* VSC = (const float*)(p.ws + OFF_VSC) + (size_t)l * 16384;
  int ci = 0, cj = 0;
  bool cvalid = lane < 50;
  {
    int rem = lane, i = 0;
    while (i < 16 && rem >= 16 / (i + 1)) { rem -= 16 / (i + 1); i++; }
    ci = i < 16 ? i : 0; cj = i < 16 ? rem : 0;
  }
  const bool b5 = (lane & 32) != 0, b4 = (lane & 16) != 0, b3 = (lane & 8) != 0;
  const int myrow = (b5 ? 4 : 0) + (b4 ? 2 : 0) + (b3 ? 1 : 0);
  int ntok = last ? NB * LSEQ : NT;
  int* tq = (int*)(p.ws + OFF_CNT) + 60 + l;
  while (true) {
    int t = 0;
    if (lane == 0) t = atomicAdd(tq, 1);
    t = __builtin_amdgcn_readfirstlane(t);
    if (t >= ntok) break;
    int g = last ? ((t >> 12) * SB + LCTX + (t & 4095)) : t;
    const u16* hrow = H + (size_t)g * HLD + lane * 16;
    uint4 xa = *(const uint4*)(hrow);
    uint4 xb = *(const uint4*)(hrow + 8);
    f2 x2[8];
    x2[0] = f2{bflo(xa.x), bfhi(xa.x)}; x2[1] = f2{bflo(xa.y), bfhi(xa.y)};
    x2[2] = f2{bflo(xa.z), bfhi(xa.z)}; x2[3] = f2{bflo(xa.w), bfhi(xa.w)};
    x2[4] = f2{bflo(xb.x), bfhi(xb.x)}; x2[5] = f2{bflo(xb.y), bfhi(xb.y)};
    x2[6] = f2{bflo(xb.z), bfhi(xb.z)}; x2[7] = f2{bflo(xb.w), bfhi(xb.w)};
    const float* tk = TK + (size_t)g * 256;
    float tv0[8], tv1[8];
#pragma unroll
    for (int hd = 0; hd < 8; hd++) { tv0[hd] = tk[(hd * 2) * 16 + ci]; tv1[hd] = tk[(hd * 2 + 1) * 16 + cj]; }
#pragma unroll
    for (int hd = 0; hd < 8; hd++) {
      float v0 = tv0[hd], v1 = tv1[hd];
      uint32_t b0 = __float_as_uint(v0), b1 = __float_as_uint(v1);
      float val = cvalid ? (__uint_as_float(b0 & ~127u) + __uint_as_float(b1 & ~127u)) : -3.0e38f;
      val = __uint_as_float((__float_as_uint(val) & ~63u) | (uint32_t)(63 - lane));
      int e = (int)((b0 & 127u) * 128u + (b1 & 127u));
      int rank = 0;
#pragma unroll
      for (int c = 0; c < 50; c++) {
        float vc = __builtin_bit_cast(float, __builtin_amdgcn_readlane(__builtin_bit_cast(int, val), c));
        rank += (vc > val) ? 1 : 0;
      }
      if (cvalid && rank < 16) { selv[hd * 16 + rank] = val; seli[hd * 16 + rank] = e; }
    }
    {
      float a0 = selv[lane], a1 = selv[64 + lane];
      int e0i = seli[lane], e1i = seli[64 + lane];
      float us0 = USC[e0i], us1 = USC[e1i], vs0 = VSC[e0i], vs1 = VSC[e1i];
      float m0 = a0, m1 = a1;
#pragma unroll
      for (int o = 8; o >= 1; o >>= 1) { m0 = fmaxf(m0, __shfl_xor(m0, o)); m1 = fmaxf(m1, __shfl_xor(m1, o)); }
      float e0 = __expf(a0 - m0), e1 = __expf(a1 - m1);
      float s0 = e0, s1 = e1;
#pragma unroll
      for (int o = 8; o >= 1; o >>= 1) { s0 += __shfl_xor(s0, o); s1 += __shfl_xor(s1, o); }
      selv[lane] = e0 / s0 * vs0; selv[64 + lane] = e1 / s1 * vs1;
      selu[lane] = us0; selu[64 + lane] = us1;
    }
    f2 acc2[8];
#pragma unroll
    for (int i = 0; i < 8; i++) acc2[i] = f2{0.f, 0.f};
    URow uA[8], uB[8];
    VRow vA[8], vB[8];
#define GATHER_LOAD(UU, VV, BT)                                                   \
    _Pragma("unroll") for (int q = 0; q < 8; q++) {                               \
      int e = __builtin_amdgcn_readfirstlane(seli[(BT) * 8 + q]);                 \
      uint4 c_ = *(const uint4*)(UT + (size_t)e * 1024 + lane * 16);              \
      UU[q].v = make_uint2(c_.x, c_.y); VV[q].v = make_uint2(c_.z, c_.w);         \
    }
#define GATHER_COMPUTE(UU, VV, BT)                                                \
    {                                                                             \
      float s[8];                                                                 \
      _Pragma("unroll") for (int q = 0; q < 8; q++) {                             \
        f2 du[8]; dec_row(UU[q], du);                                             \
        f2 d2 = du[0] * x2[0];                                                    \
        d2 += du[1] * x2[1]; d2 += du[2] * x2[2]; d2 += du[3] * x2[3];            \
        d2 += du[4] * x2[4]; d2 += du[5] * x2[5]; d2 += du[6] * x2[6]; d2 += du[7] * x2[7]; \
        s[q] = d2[0] + d2[1];                                                     \
      }                                                                           \
      float t4[4];                                                                \
      _Pragma("unroll") for (int i = 0; i < 4; i++) {                             \
        float send = b5 ? s[i] : s[i + 4];                                        \
        float keep = b5 ? s[i + 4] : s[i];                                        \
        t4[i] = keep + __shfl_xor(send, 32);                                      \
      }                                                                           \
      float t2[2];                                                                \
      _Pragma("unroll") for (int i = 0; i < 2; i++) {                             \
        float send = b4 ? t4[i] : t4[i + 2];                                      \
        float keep = b4 ? t4[i + 2] : t4[i];                                      \
        t2[i] = keep + __shfl_xor(send, 16);                                      \
      }                                                                           \
      float tv;                                                                   \
      {                                                                           \
        float send = b3 ? t2[0] : t2[1];                                          \
        float keep = b3 ? t2[1] : t2[0];                                          \
        tv = keep + __shfl_xor(send, 8);                                          \
      }                                                                           \
      tv += __shfl_xor(tv, 4); tv += __shfl_xor(tv, 2); tv += __shfl_xor(tv, 1);  \
      float wmine = selv[(BT) * 8 + myrow] * gelu_tanh(tv * selu[(BT) * 8 + myrow]); \
      _Pragma("unroll") for (int q = 0; q < 8; q++) {                             \
        const int src_lane = ((q >> 2) & 1) * 32 + ((q >> 1) & 1) * 16 + (q & 1) * 8; \
        float wq = __builtin_bit_cast(float, __builtin_amdgcn_readlane(__builtin_bit_cast(int, wmine), src_lane)); \
        f2 wq2 = f2{wq, wq};                                                      \
        f2 dv[8]; dec_row(VV[q], dv);                                             \
        acc2[0] += wq2 * dv[0]; acc2[1] += wq2 * dv[1]; acc2[2] += wq2 * dv[2]; acc2[3] += wq2 * dv[3]; \
        acc2[4] += wq2 * dv[4]; acc2[5] += wq2 * dv[5]; acc2[6] += wq2 * dv[6]; acc2[7] += wq2 * dv[7]; \
      }                                                                           \
    }
    GATHER_LOAD(uA, vA, 0)
    for (int bt = 0; bt < 16; bt += 2) {
      GATHER_LOAD(uB, vB, bt + 1)
      GATHER_COMPUTE(uA, vA, bt)
      if (bt + 2 < 16) { GATHER_LOAD(uA, vA, bt + 2) }
      GATHER_COMPUTE(uB, vB, bt + 1)
    }
#undef GATHER_LOAD
#undef GATHER_COMPUTE
    float acc[16];
#pragma unroll
    for (int i = 0; i < 8; i++) { acc[2 * i] = acc2[i][0]; acc[2 * i + 1] = acc2[i][1]; }
    float* xr = res_dst(p, g) + lane * 16;
    float* xw = dry ? ((float*)(p.ws + OFF_YF) + (size_t)(g & 1023) * 1024 + lane * 16) : xr;
    const float* mv = mod_vec(p, l, g) + lane * 16;
    float xn[16];
    float ss = 0.f;
#pragma unroll
    for (int q4 = 0; q4 < 4; q4++) {
      float4 xo = *(const float4*)(xr + q4 * 4);
      float4 gt = *(const float4*)(mv + 5120 + q4 * 4);
      float n0 = xo.x + gt.x * acc[q4 * 4 + 0];
      float n1 = xo.y + gt.y * acc[q4 * 4 + 1];
      float n2 = xo.z + gt.z * acc[q4 * 4 + 2];
      float n3 = xo.w + gt.w * acc[q4 * 4 + 3];
      xn[q4 * 4 + 0] = n0; xn[q4 * 4 + 1] = n1; xn[q4 * 4 + 2] = n2; xn[q4 * 4 + 3] = n3;
      ss += n0 * n0 + n1 * n1 + n2 * n2 + n3 * n3;
    }
    ss = wave_sum(ss);
    float rn = rsqrtf(ss * (1.f / 1024.f) + 1e-6f);
    if (last) {
      const float* gf = p.in[34] + lane * 16;
#pragma unroll
      for (int q4 = 0; q4 < 4; q4++) {
        float4 gg = *(const float4*)(gf + q4 * 4);
        *(float4*)(xw + q4 * 4) = make_float4(xn[q4 * 4 + 0] * rn * gg.x, xn[q4 * 4 + 1] * rn * gg.y, xn[q4 * 4 + 2] * rn * gg.z, xn[q4 * 4 + 3] * rn * gg.w);
      }
    } else {
      const float* gn = p.in[6] + (size_t)(l + 1) * DM + lane * 16;
      const float* mv2 = mod_vec(p, l + 1, g) + lane * 16;
      u16* hw = dry ? ((u16*)(p.ws + OFF_YB) + (size_t)(g & 1023) * 1024 + lane * 16) : ((u16*)(p.ws + OFF_HBUF) + (size_t)g * HLD + lane * 16);
#pragma unroll
      for (int q4 = 0; q4 < 4; q4++) {
        *(float4*)(xw + q4 * 4) = make_float4(xn[q4 * 4 + 0], xn[q4 * 4 + 1], xn[q4 * 4 + 2], xn[q4 * 4 + 3]);
        float4 gg = *(const float4*)(gn + q4 * 4);
        float4 sc = *(const float4*)(mv2 + 1024 + q4 * 4);
        float4 sh = *(const float4*)(mv2 + q4 * 4);
        float h0 = xn[q4 * 4 + 0] * rn * gg.x * (1.f + sc.x) + sh.x;
        float h1 = xn[q4 * 4 + 1] * rn * gg.y * (1.f + sc.y) + sh.y;
        float h2 = xn[q4 * 4 + 2] * rn * gg.z * (1.f + sc.z) + sh.z;
        float h3 = xn[q4 * 4 + 3] * rn * gg.w * (1.f + sc.w) + sh.w;
        *(uint2*)(hw + q4 * 4) = make_uint2(pack2(h0, h1), pack2(h2, h3));
      }
    }
  }
}

#define XB_TMO      128
#define XB_XCNT(j)  (256  + 64 * (j))
#define XB_XSUB(j)  (1280 + 64 * (j))
#define XB_XGEN(j)  (2304 + 64 * (j))
#define XB_TOP      3328
#define XB_TOPGEN   3392
#define XCD_BAR_WORDS 3456
#define XB_SPIN_CAP (1u << 18)
#define LAS __attribute__((address_space(3)))

__device__ __forceinline__ unsigned xb_ld(unsigned* p)              { return __hip_atomic_load(p, __ATOMIC_RELAXED, __HIP_MEMORY_SCOPE_AGENT); }
__device__ __forceinline__ unsigned xb_add(unsigned* p, unsigned v) { return __hip_atomic_fetch_add(p, v, __ATOMIC_RELAXED, __HIP_MEMORY_SCOPE_AGENT); }
__device__ __forceinline__ unsigned xb_xcc_id() { return (unsigned)__builtin_amdgcn_s_getreg((3 << 11) | 20) & 0xFu; }
#define XB_SPIN(cond, bar) do { unsigned _sp = 0; while (cond) { __builtin_amdgcn_s_sleep(1); \
    if ((++_sp & 255u) == 0u) { if (xb_ld(&(bar)[XB_TMO])) break; if (_sp > XB_SPIN_CAP) { atomicAdd(&(bar)[XB_TMO], 1u); break; } } } } while (0)

struct XcdBarrier {
    unsigned* bar; unsigned x;
    volatile LAS unsigned* st;
};

__device__ __forceinline__ XcdBarrier xcd_barrier_post(unsigned* bar, volatile LAS unsigned* st) {
    XcdBarrier b; b.bar = bar; b.x = xb_xcc_id(); b.st = st;
    if (threadIdx.x == 0) (void)xb_add(&bar[XB_XCNT(b.x)], 1u);
    return b;
}
__device__ __forceinline__ void xcd_barrier_complete(unsigned* bar, unsigned x, unsigned& nloc, unsigned& nx) {
    const unsigned G = gridDim.x * gridDim.y * gridDim.z;
    unsigned sum, cnt, mine, sp = 0u;
    for (;;) {
        sum = 0u; cnt = 0u; mine = 0u;
#pragma unroll
        for (unsigned j = 0; j < 16; ++j) { const unsigned c = xb_ld(&bar[XB_XCNT(j)]); sum += c; cnt += (c > 0u) ? 1u : 0u; mine = (j == x) ? c : mine; }
        if (sum == G) break;
        __builtin_amdgcn_s_sleep(1);
        if ((++sp & 255u) == 0u) { if (xb_ld(&bar[XB_TMO])) break; if (sp > XB_SPIN_CAP) { atomicAdd(&bar[XB_TMO], 1u); break; } }
    }
    nloc = mine > 0u ? mine : 1u; nx = cnt > 0u ? cnt : 1u;
}

__device__ __forceinline__ void xcd_barrier(const XcdBarrier& b) {
    asm volatile("s_waitcnt vmcnt(0)" ::: "memory");
    __syncthreads();
    if (threadIdx.x == 0) {
        unsigned* bar = b.bar;
        __builtin_amdgcn_s_waitcnt(0);
        unsigned nloc = b.st[0], nx = b.st[1];
        if (nloc == 0u) { xcd_barrier_complete(bar, b.x, nloc, nx); b.st[0] = nloc; b.st[1] = nx; }
        const unsigned old = xb_add(&bar[XB_XSUB(b.x)], 1u);
        const unsigned gen = old / nloc;
        if (old + 1u == (gen + 1u) * nloc) {
            __builtin_amdgcn_fence(__ATOMIC_RELEASE, "agent");
            asm volatile("s_waitcnt vmcnt(0)" ::: "memory");
            const unsigned og = xb_add(&bar[XB_TOP], 1u);
            const unsigned tg = og / nx;
            if (og + 1u == (tg + 1u) * nx) xb_add(&bar[XB_TOPGEN], 1u);
            else XB_SPIN(xb_ld(&bar[XB_TOPGEN]) == tg, bar);
            __builtin_amdgcn_fence(__ATOMIC_ACQUIRE, "agent");
            xb_add(&bar[XB_XGEN(b.x)], 1u);
            asm volatile("s_waitcnt vmcnt(0)" ::: "memory");
        } else {
            XB_SPIN(xb_ld(&bar[XB_XGEN(b.x)]) == gen, bar);
            __builtin_amdgcn_fence(__ATOMIC_ACQUIRE, "agent");
            asm volatile("s_waitcnt vmcnt(0)" ::: "memory");
        }
    }
    __syncthreads();
}


__global__ void __launch_bounds__(NTHREADS, 2) mega(Params p) {
  cg::grid_group grid = cg::this_grid();
  __shared__ __attribute__((aligned(16))) char smem[SMEM_BYTES];
  if (threadIdx.x == 0) *(uint4*)(smem + SMEM_BYTES - 32) = make_uint4(0u, 0u, 0u, 0u);
  __syncthreads();
  XcdBarrier xb = xcd_barrier_post((unsigned*)(p.ws + OFF_BAR), (volatile LAS unsigned*)(smem + SMEM_BYTES - 32));
  int* census = (int*)(p.ws + OFF_BAR + 14336);
  if (threadIdx.x == 0) *(int*)(smem + SMEM_BYTES - 16) = atomicAdd(census + (xb.x & 15), 1);
  __syncthreads();
  int myrank = *(int*)(smem + SMEM_BYTES - 16);
  phase_prep(p, (float*)smem);
  if (threadIdx.x == 0) {
    int* modcnt = (int*)(p.ws + OFF_BAR + 15360);
    unsigned sp = 0;
    while (__hip_atomic_load(modcnt, __ATOMIC_RELAXED, __HIP_MEMORY_SCOPE_AGENT) < 192) {
      __builtin_amdgcn_s_sleep(2);
      if (++sp > (1u << 22)) break;
    }
    __builtin_amdgcn_fence(__ATOMIC_ACQUIRE, "agent");
    asm volatile("s_waitcnt vmcnt(0)" ::: "memory");
  }
  __syncthreads();
  phase_norm(p, 0, 0, false);
  grid.sync();
  Loc lc;
  {
    bool ok = true;
    for (int j = 0; j < 16; j++) {
      int c = __hip_atomic_load(census + j, __ATOMIC_RELAXED, __HIP_MEMORY_SCOPE_AGENT);
      if (j < 8 ? (c <= 0) : (c != 0)) ok = false;
    }
    if (ok) { lc.xq = (int)xb.x; lc.lb = myrank; lc.nl = __hip_atomic_load(census + xb.x, __ATOMIC_RELAXED, __HIP_MEMORY_SCOPE_AGENT); }
    else { lc.xq = blockIdx.x & 7; lc.lb = blockIdx.x >> 3; lc.nl = gridDim.x >> 3; }
    lc.xq = __builtin_amdgcn_readfirstlane(lc.xq); lc.lb = __builtin_amdgcn_readfirstlane(lc.lb); lc.nl = __builtin_amdgcn_readfirstlane(lc.nl);
  }
#ifdef PROBE_SYNC10
  for (int i = 0; i < 10; i++) xcd_barrier(xb);
#endif
  for (int l = 0; l < 2; l++) {
    bool last = (l == 1);
    phase_inproj(p, l, (u16*)smem, lc);
    xcd_barrier(xb);
    phase_mix(p, l, last, smem, l, lc);
    xcd_barrier(xb);
#ifdef PROBE_MIX2
    phase_mix(p, l, last, smem, l + 2, lc, PROBE_MIX2);
    xcd_barrier(xb);
#endif
    phase_glu_pw(p, l, last, (u16*)smem);
    xcd_barrier(xb);
#ifdef PROBE_GLU2
    phase_glu_pw(p, l, last, (u16*)smem);
    xcd_barrier(xb);
#endif
    phase_outproj(p, l, last, (u16*)smem, lc);
    xcd_barrier(xb);
    phase_norm(p, l, 1, last);
    xcd_barrier(xb);
    phase_peerq(p, l, last, (u16*)smem, lc);
    xcd_barrier(xb);
#ifdef PROBE_PEERQ2
    phase_peerq(p, l, last, (u16*)smem, lc);
    xcd_barrier(xb);
#endif
#ifdef PROBE_GATHER2
    phase_gather(p, l, last, smem, true);
    xcd_barrier(xb);
#endif
    phase_gather(p, l, last, smem);
    if (!last) xcd_barrier(xb);
  }
}

extern "C" void kernel_launch(void* const* d_in, const int* in_sizes, int n_in,
                              void* d_out, int out_size, void* d_ws, size_t ws_size,
                              hipStream_t stream) {
  static int grid_blocks = 0;
  if (!grid_blocks) {
    int dev = 0, cus = 0, per_cu = 0;
    (void)hipGetDevice(&dev);
    (void)hipDeviceGetAttribute(&cus, hipDeviceAttributeMultiprocessorCount, dev);
    (void)hipOccupancyMaxActiveBlocksPerMultiprocessor(&per_cu, mega, NTHREADS, 0);
    if (per_cu > 2) per_cu = 2;
    if (per_cu < 1) per_cu = 1;
    grid_blocks = cus * per_cu;
  }
  Params p{};
  for (int i = 0; i < 35; i++) p.in[i] = (const float*)d_in[i];
  p.out = (float*)d_out;
  p.ws = (char*)d_ws;
  (void)hipMemsetAsync((char*)d_ws + OFF_BAR, 0, 16384, stream);
  void* args[] = {&p};
  hipError_t e = hipLaunchCooperativeKernel((void*)mega, dim3(grid_blocks), dim3(NTHREADS), args, 0, stream);
  if (e != hipSuccess) fprintf(stderr, "coop launch failed: %s (grid %d)\n", hipGetErrorString(e), grid_blocks);
}
```

```cpp
#include <hip/hip_runtime.h>
#include <hip/hip_cooperative_groups.h>
#include <cstdio>
#include <cstdint>
namespace cg = cooperative_groups;

typedef unsigned short u16;
typedef __attribute__((ext_vector_type(8))) short bf16x8;
typedef __attribute__((ext_vector_type(4))) float f32x4;
typedef __attribute__((ext_vector_type(16))) float f32x16;
typedef __attribute__((ext_vector_type(2))) __bf16 bf16x2_t;

#define DM 1024
#define NB 8
#define LSEQ 4096
#define LCTX 256
#define SB 4352
#define NT (NB * SB)
#define NTHREADS 256
#define HLD 1088
#define SMEM_BYTES 77824

constexpr size_t SZ_XC = (size_t)NB * LCTX * DM * 4;
constexpr size_t SZ_HBUF = (size_t)NT * HLD * 2;
constexpr size_t SZ_QB = (size_t)NT * 512 * 2;
constexpr size_t SZ_UB = (size_t)NT * 256 * 2;
constexpr size_t SZ_Y = (size_t)NT * 256 * 4;
constexpr size_t OFF_XC = 0;
constexpr size_t OFF_HBUF = OFF_XC + SZ_XC;
constexpr size_t OFF_QB = OFF_HBUF + SZ_HBUF;
constexpr size_t OFF_KB = OFF_QB + SZ_QB;
constexpr size_t OFF_VT = OFF_KB + SZ_QB;
constexpr size_t OFF_UB = OFF_VT + SZ_QB;
constexpr size_t OFF_ZB = OFF_UB + SZ_UB;
constexpr size_t OFF_YF = OFF_ZB + SZ_QB;
constexpr size_t OFF_YB = OFF_YF + SZ_Y;
constexpr size_t OFF_CVIN = OFF_YB + SZ_Y;
constexpr size_t OFF_WINT = OFF_CVIN + SZ_UB;
constexpr size_t OFF_WOUTT = OFF_WINT + (size_t)2 * 2304 * HLD * 2;
constexpr size_t OFF_WQT = OFF_WOUTT + (size_t)2 * 1024 * HLD * 2;
constexpr size_t OFF_WGLUT = OFF_WQT + (size_t)2 * 2048 * HLD * 2;
constexpr size_t OFF_WPWT = OFF_WGLUT + (size_t)2 * 256 * 256 * 2;
constexpr size_t OFF_SUBK = OFF_WPWT + (size_t)2 * 256 * 256 * 2;
constexpr size_t OFF_UTAB = OFF_SUBK + (size_t)2 * 8 * 2 * 128 * 128 * 2;
constexpr size_t OFF_VTAB = OFF_UTAB + (size_t)2 * 16384 * 1024;
constexpr size_t OFF_USC = OFF_VTAB + (size_t)2 * 16384 * 1024;
constexpr size_t OFF_VSC = OFF_USC + (size_t)2 * 16384 * 4;
constexpr size_t OFF_MLAT = OFF_VSC + (size_t)2 * 16384 * 4;
constexpr size_t OFF_MCTX = OFF_MLAT + (size_t)2 * 8 * 6144 * 4;
constexpr size_t OFF_S5A = OFF_MCTX + (size_t)2 * 6144 * 4;
constexpr size_t OFF_S5BB = OFF_S5A + (size_t)2 * 4096 * 4;
constexpr size_t OFF_ROPE = OFF_S5BB + (size_t)2 * 65536 * 4;
constexpr size_t OFF_CNT = OFF_ROPE + (size_t)2 * 1024 * 4;
constexpr size_t OFF_G = OFF_CNT + 256;
constexpr size_t OFF_BAR = OFF_G + SZ_UB;
constexpr size_t WS_TOTAL = OFF_BAR + 16384;

struct Params {
  const float* in[35];
  float* out;
  char* ws;
};

__device__ __forceinline__ uint32_t pack2(float a, float b) {
  bf16x2_t r; r[0] = (__bf16)a; r[1] = (__bf16)b; return __builtin_bit_cast(uint32_t, r);
}
__device__ __forceinline__ u16 f2bf(float a) { return (u16)(pack2(a, 0.f) & 0xFFFFu); }
__device__ __forceinline__ float bflo(uint32_t u) { return __uint_as_float(u << 16); }
__device__ __forceinline__ float bfhi(uint32_t u) { return __uint_as_float(u & 0xFFFF0000u); }
__device__ __forceinline__ float bf2f(u16 h) { return __uint_as_float(((uint32_t)h) << 16); }
__device__ __forceinline__ float sigmoidf_(float x) { return 1.f / (1.f + __expf(-x)); }
__device__ __forceinline__ float siluf_(float x) { return x * sigmoidf_(x); }
__device__ __forceinline__ float gelu_tanh(float x) {
  float z = 0.7978845608028654f * (x + 0.044715f * x * x * x);
  float t = 1.f - 2.f / (__expf(2.f * z) + 1.f);
  return 0.5f * x * (1.f + t);
}
__device__ __forceinline__ float wave_sum(float v) {
#pragma unroll
  for (int o = 32; o >= 1; o >>= 1) v += __shfl_xor(v, o);
  return v;
}
__device__ __forceinline__ float dot2bf(uint32_t a, uint32_t b, float c) {
  return __builtin_amdgcn_fdot2_f32_bf16(__builtin_bit_cast(bf16x2_t, a), __builtin_bit_cast(bf16x2_t, b), c, false);
}

#ifndef U_FP4
#define U_FP4 1
#endif
#ifndef V_FP4
#define V_FP4 1
#endif
typedef __attribute__((ext_vector_type(2))) float f2;
struct Row8 { int4 v; };
struct Row4 { uint2 v; };
__device__ __forceinline__ void dec_row(const Row8& r, f2 (&o)[8]) {
  o[0] = __builtin_amdgcn_cvt_pk_f32_fp8(r.v.x, false); o[1] = __builtin_amdgcn_cvt_pk_f32_fp8(r.v.x, true);
  o[2] = __builtin_amdgcn_cvt_pk_f32_fp8(r.v.y, false); o[3] = __builtin_amdgcn_cvt_pk_f32_fp8(r.v.y, true);
  o[4] = __builtin_amdgcn_cvt_pk_f32_fp8(r.v.z, false); o[5] = __builtin_amdgcn_cvt_pk_f32_fp8(r.v.z, true);
  o[6] = __builtin_amdgcn_cvt_pk_f32_fp8(r.v.w, false); o[7] = __builtin_amdgcn_cvt_pk_f32_fp8(r.v.w, true);
}
__device__ __forceinline__ void dec_row(const Row4& r, f2 (&o)[8]) {
  o[0] = __builtin_amdgcn_cvt_scalef32_pk_f32_fp4(r.v.x, 1.0f, 0); o[1] = __builtin_amdgcn_cvt_scalef32_pk_f32_fp4(r.v.x, 1.0f, 1);
  o[2] = __builtin_amdgcn_cvt_scalef32_pk_f32_fp4(r.v.x, 1.0f, 2); o[3] = __builtin_amdgcn_cvt_scalef32_pk_f32_fp4(r.v.x, 1.0f, 3);
  o[4] = __builtin_amdgcn_cvt_scalef32_pk_f32_fp4(r.v.y, 1.0f, 0); o[5] = __builtin_amdgcn_cvt_scalef32_pk_f32_fp4(r.v.y, 1.0f, 1);
  o[6] = __builtin_amdgcn_cvt_scalef32_pk_f32_fp4(r.v.y, 1.0f, 2); o[7] = __builtin_amdgcn_cvt_scalef32_pk_f32_fp4(r.v.y, 1.0f, 3);
}
__device__ __forceinline__ void load_row(Row8& r, const unsigned char* tab, int e, int lane) { r.v = *(const int4*)(tab + (size_t)e * 1024 + lane * 16); }
__device__ __forceinline__ void load_row(Row4& r, const unsigned char* tab, int e, int lane) { r.v = *(const uint2*)(tab + (size_t)e * 512 + lane * 8); }
#if U_FP4
typedef Row4 URow;
#define U_ROWB 512
#else
typedef Row8 URow;
#define U_ROWB 1024
#endif
#if V_FP4
typedef Row4 VRow;
#define V_ROWB 512
#else
typedef Row8 VRow;
#define V_ROWB 1024
#endif

__device__ __forceinline__ int otid() { int t = __builtin_amdgcn_workitem_id_x(); asm volatile("" : "+v"(t)); return t; }
__device__ __forceinline__ int opaque_zero() { int z = 0; asm volatile("" : "+s"(z)); return z; }

__device__ __forceinline__ const float* res_src(const Params& p, int l, int g) {
  int b = g / SB, s = g - b * SB;
  if (s < LCTX) return (l == 0 ? p.in[2] : (const float*)(p.ws + OFF_XC)) + ((size_t)(b * LCTX + s)) * DM;
  return (l == 0 ? p.in[0] : (const float*)p.out) + ((size_t)(b * LSEQ + s - LCTX)) * DM;
}
__device__ __forceinline__ float* res_dst(const Params& p, int g) {
  int b = g / SB, s = g - b * SB;
  if (s < LCTX) return (float*)(p.ws + OFF_XC) + ((size_t)(b * LCTX + s)) * DM;
  return p.out + ((size_t)(b * LSEQ + s - LCTX)) * DM;
}
__device__ __forceinline__ const float* mod_vec(const Params& p, int l, int g) {
  int b = g / SB, s = g - b * SB;
  if (s < LCTX) return (const float*)(p.ws + OFF_MCTX) + (size_t)l * 6144;
  return (const float*)(p.ws + OFF_MLAT) + ((size_t)l * 8 + b) * 6144;
}

struct Loc { int xq, lb, nl; };

__device__ __forceinline__ void transpose_convert_tile(const float* src, int K, int N, u16* dst, int ldd, int k0, int n0, float* sm) {
  int tid = otid();
  __syncthreads();
#pragma unroll
  for (int ps = 0; ps < 4; ps++) {
    int r = ps * 16 + (tid >> 4), c4 = (tid & 15) * 4;
    float4 v = *(const float4*)(src + (size_t)(k0 + r) * N + n0 + c4);
    sm[r * 65 + c4 + 0] = v.x; sm[r * 65 + c4 + 1] = v.y; sm[r * 65 + c4 + 2] = v.z; sm[r * 65 + c4 + 3] = v.w;
  }
  __syncthreads();
  int n = tid >> 2, kq = (tid & 3) * 16;
  uint32_t pk[8];
#pragma unroll
  for (int i = 0; i < 8; i++) pk[i] = pack2(sm[(kq + 2 * i) * 65 + n], sm[(kq + 2 * i + 1) * 65 + n]);
  uint4* d = (uint4*)(dst + (size_t)(n0 + n) * ldd + k0 + kq);
  d[0] = make_uint4(pk[0], pk[1], pk[2], pk[3]);
  d[1] = make_uint4(pk[4], pk[5], pk[6], pk[7]);
}

__device__ __forceinline__ void mod_item(const Params& p, int item, float* sm) {
  int l = item / 96, cg = item % 96;
  int tid = otid();
  float* sc = sm;
  float* red = sm + 9 * 1024;
  __syncthreads();
  for (int idx = tid; idx < 9 * 1024; idx += NTHREADS) {
    int r = idx >> 10, k = idx & 1023;
    float v = (r < 8) ? p.in[1][r * 1024 + k] : p.in[3][k];
    sc[idx] = siluf_(v);
  }
  __syncthreads();
  int kg = tid >> 6, col = tid & 63;
  const float* w = p.in[4] + (size_t)l * 1024 * 6144 + cg * 64 + col;
  float acc[9];
#pragma unroll
  for (int r = 0; r < 9; r++) acc[r] = 0.f;
  for (int k0 = kg * 256; k0 < kg * 256 + 256; k0 += 16) {
    float wv[16];
#pragma unroll
    for (int u = 0; u < 16; u++) wv[u] = w[(size_t)(k0 + u) * 6144];
#pragma unroll
    for (int u = 0; u < 16; u += 4) {
#pragma unroll
      for (int r = 0; r < 9; r++) {
        float4 s4 = *(const float4*)(sc + r * 1024 + k0 + u);
        acc[r] += s4.x * wv[u] + s4.y * wv[u + 1] + s4.z * wv[u + 2] + s4.w * wv[u + 3];
      }
    }
  }
#pragma unroll
  for (int r = 0; r < 9; r++) red[(kg * 9 + r) * 64 + col] = acc[r];
  __syncthreads();
  for (int idx = tid; idx < 9 * 64; idx += NTHREADS) {
    int r = idx >> 6, c = idx & 63;
    float s = red[(0 * 9 + r) * 64 + c] + red[(1 * 9 + r) * 64 + c] + red[(2 * 9 + r) * 64 + c] + red[(3 * 9 + r) * 64 + c];
    s += p.in[5][l * 6144 + cg * 64 + c];
    if (r < 8) ((float*)(p.ws + OFF_MLAT))[((size_t)l * 8 + r) * 6144 + cg * 64 + c] = s;
    else ((float*)(p.ws + OFF_MCTX))[(size_t)l * 6144 + cg * 64 + c] = s;
  }
}

__device__ __forceinline__ void s5disc_item(const Params& p, int item) {
  int idx = item * NTHREADS + otid();
  if (idx >= 4096) return;
  float a_re = p.in[15][idx], a_im = p.in[16][idx], ldt = p.in[17][idx];
  float dt = expf(ldt);
  float mag = expf(a_re * dt);
  float ar = mag * cosf(a_im * dt), ai = mag * sinf(a_im * dt);
  float xr = ar - 1.f;
  float den = a_re * a_re + a_im * a_im;
  float cr = (xr * a_re + ai * a_im) / den;
  float ci = (ai * a_re - xr * a_im) / den;
  float* A = (float*)(p.ws + OFF_S5A);
  A[idx] = ar; A[4096 + idx] = ai;
  float* BB = (float*)(p.ws + OFF_S5BB);
#pragma unroll
  for (int h = 0; h < 16; h++) {
    float br = p.in[18][(size_t)idx * 16 + h], bi = p.in[19][(size_t)idx * 16 + h];
    BB[(size_t)idx * 16 + h] = cr * br - ci * bi;
    BB[65536 + (size_t)idx * 16 + h] = cr * bi + ci * br;
  }
}

__device__ __forceinline__ void convert_chunk(const float* src, u16* dst, size_t base) {
#pragma unroll
  for (int ps = 0; ps < 4; ps++) {
    size_t o = base + (size_t)ps * 2048 + (size_t)otid() * 8;
    float4 a = *(const float4*)(src + o), b = *(const float4*)(src + o + 4);
    *(uint4*)(dst + o) = make_uint4(pack2(a.x, a.y), pack2(a.z, a.w), pack2(b.x, b.y), pack2(b.z, b.w));
  }
}

__device__ __forceinline__ void fp8_rows_item(const float* src, unsigned char* dst, float* scl, int row0) {
  int tid = otid(), lane = tid & 63, w = tid >> 6;
  int row = row0 + w;
  const float* s = src + (size_t)row * 1024 + lane * 16;
  float4 a = *(const float4*)(s), b = *(const float4*)(s + 4), c = *(const float4*)(s + 8), d = *(const float4*)(s + 12);
  float mx = fmaxf(fmaxf(fmaxf(fabsf(a.x), fabsf(a.y)), fmaxf(fabsf(a.z), fabsf(a.w))), fmaxf(fmaxf(fabsf(b.x), fabsf(b.y)), fmaxf(fabsf(b.z), fabsf(b.w))));
  mx = fmaxf(mx, fmaxf(fmaxf(fmaxf(fabsf(c.x), fabsf(c.y)), fmaxf(fabsf(c.z), fabsf(c.w))), fmaxf(fmaxf(fabsf(d.x), fabsf(d.y)), fmaxf(fabsf(d.z), fabsf(d.w)))));
#pragma unroll
  for (int o = 32; o >= 1; o >>= 1) mx = fmaxf(mx, __shfl_xor(mx, o));
  float sc = (mx > 0.f) ? 224.f / mx : 1.f;
  int p0 = __builtin_amdgcn_cvt_pk_fp8_f32(a.x * sc, a.y * sc, 0, false); p0 = __builtin_amdgcn_cvt_pk_fp8_f32(a.z * sc, a.w * sc, p0, true);
  int p1 = __builtin_amdgcn_cvt_pk_fp8_f32(b.x * sc, b.y * sc, 0, false); p1 = __builtin_amdgcn_cvt_pk_fp8_f32(b.z * sc, b.w * sc, p1, true);
  int p2 = __builtin_amdgcn_cvt_pk_fp8_f32(c.x * sc, c.y * sc, 0, false); p2 = __builtin_amdgcn_cvt_pk_fp8_f32(c.z * sc, c.w * sc, p2, true);
  int p3 = __builtin_amdgcn_cvt_pk_fp8_f32(d.x * sc, d.y * sc, 0, false); p3 = __builtin_amdgcn_cvt_pk_fp8_f32(d.z * sc, d.w * sc, p3, true);
  *(int4*)(dst + (size_t)row * 1024 + lane * 16) = make_int4(p0, p1, p2, p3);
  if (lane == 0) scl[row] = (mx > 0.f) ? mx / 224.f : 1.f;
}

__device__ __forceinline__ void fp4_rows_item(const float* src, unsigned char* dst, float* scl, int row0) {
  int tid = otid(), lane = tid & 63, w = tid >> 6;
  int row = row0 + w;
  const float* s = src + (size_t)row * 1024 + lane * 16;
  float4 a = *(const float4*)(s), b = *(const float4*)(s + 4), c = *(const float4*)(s + 8), d = *(const float4*)(s + 12);
  float mx = fmaxf(fmaxf(fmaxf(fabsf(a.x), fabsf(a.y)), fmaxf(fabsf(a.z), fabsf(a.w))), fmaxf(fmaxf(fabsf(b.x), fabsf(b.y)), fmaxf(fabsf(b.z), fabsf(b.w))));
  mx = fmaxf(mx, fmaxf(fmaxf(fmaxf(fabsf(c.x), fabsf(c.y)), fmaxf(fabsf(c.z), fabsf(c.w))), fmaxf(fmaxf(fabsf(d.x), fabsf(d.y)), fmaxf(fabsf(d.z), fabsf(d.w)))));
#pragma unroll
  for (int o = 32; o >= 1; o >>= 1) mx = fmaxf(mx, __shfl_xor(mx, o));
  float sc = (mx > 0.f) ? 6.f / mx : 1.f;
  unsigned p0 = 0, p1 = 0;
  p0 = __builtin_amdgcn_cvt_scalef32_pk_fp4_f32(p0, a.x * sc, a.y * sc, 1.0f, 0);
  p0 = __builtin_amdgcn_cvt_scalef32_pk_fp4_f32(p0, a.z * sc, a.w * sc, 1.0f, 1);
  p0 = __builtin_amdgcn_cvt_scalef32_pk_fp4_f32(p0, b.x * sc, b.y * sc, 1.0f, 2);
  p0 = __builtin_amdgcn_cvt_scalef32_pk_fp4_f32(p0, b.z * sc, b.w * sc, 1.0f, 3);
  p1 = __builtin_amdgcn_cvt_scalef32_pk_fp4_f32(p1, c.x * sc, c.y * sc, 1.0f, 0);
  p1 = __builtin_amdgcn_cvt_scalef32_pk_fp4_f32(p1, c.z * sc, c.w * sc, 1.0f, 1);
  p1 = __builtin_amdgcn_cvt_scalef32_pk_fp4_f32(p1, d.x * sc, d.y * sc, 1.0f, 2);
  p1 = __builtin_amdgcn_cvt_scalef32_pk_fp4_f32(p1, d.z * sc, d.w * sc, 1.0f, 3);
  *(uint2*)(dst + (size_t)row * 1024 + lane * 16) = make_uint2(p0, p1);
  if (lane == 0) scl[row] = (mx > 0.f) ? mx / 6.f : 1.f;
}

__device__ __forceinline__ void fp4_uv_item(const float* usrc, const float* vsrc, unsigned char* dst, float* usc, float* vsc, int row0) {
  int tid = otid(), lane = tid & 63, w = tid >> 6;
  int row = row0 + w;
  const float* su = usrc + (size_t)row * 1024 + lane * 16;
  const float* sv = vsrc + (size_t)row * 1024 + lane * 16;
  float4 a[4], b[4];
#pragma unroll
  for (int q = 0; q < 4; q++) { a[q] = *(const float4*)(su + q * 4); b[q] = *(const float4*)(sv + q * 4); }
  float mu = 0.f, mv = 0.f;
#pragma unroll
  for (int q = 0; q < 4; q++) {
    mu = fmaxf(mu, fmaxf(fmaxf(fabsf(a[q].x), fabsf(a[q].y)), fmaxf(fabsf(a[q].z), fabsf(a[q].w))));
    mv = fmaxf(mv, fmaxf(fmaxf(fabsf(b[q].x), fabsf(b[q].y)), fmaxf(fabsf(b[q].z), fabsf(b[q].w))));
  }
#pragma unroll
  for (int o = 32; o >= 1; o >>= 1) { mu = fmaxf(mu, __shfl_xor(mu, o)); mv = fmaxf(mv, __shfl_xor(mv, o)); }
  float su_ = (mu > 0.f) ? 6.f / mu : 1.f, sv_ = (mv > 0.f) ? 6.f / mv : 1.f;
  unsigned p0 = 0, p1 = 0, p2 = 0, p3 = 0;
  p0 = __builtin_amdgcn_cvt_scalef32_pk_fp4_f32(p0, a[0].x * su_, a[0].y * su_, 1.0f, 0);
  p0 = __builtin_amdgcn_cvt_scalef32_pk_fp4_f32(p0, a[0].z * su_, a[0].w * su_, 1.0f, 1);
  p0 = __builtin_amdgcn_cvt_scalef32_pk_fp4_f32(p0, a[1].x * su_, a[1].y * su_, 1.0f, 2);
  p0 = __builtin_amdgcn_cvt_scalef32_pk_fp4_f32(p0, a[1].z * su_, a[1].w * su_, 1.0f, 3);
  p1 = __builtin_amdgcn_cvt_scalef32_pk_fp4_f32(p1, a[2].x * su_, a[2].y * su_, 1.0f, 0);
  p1 = __builtin_amdgcn_cvt_scalef32_pk_fp4_f32(p1, a[2].z * su_, a[2].w * su_, 1.0f, 1);
  p1 = __builtin_amdgcn_cvt_scalef32_pk_fp4_f32(p1, a[3].x * su_, a[3].y * su_, 1.0f, 2);
  p1 = __builtin_amdgcn_cvt_scalef32_pk_fp4_f32(p1, a[3].z * su_, a[3].w * su_, 1.0f, 3);
  p2 = __builtin_amdgcn_cvt_scalef32_pk_fp4_f32(p2, b[0].x * sv_, b[0].y * sv_, 1.0f, 0);
  p2 = __builtin_amdgcn_cvt_scalef32_pk_fp4_f32(p2, b[0].z * sv_, b[0].w * sv_, 1.0f, 1);
  p2 = __builtin_amdgcn_cvt_scalef32_pk_fp4_f32(p2, b[1].x * sv_, b[1].y * sv_, 1.0f, 2);
  p2 = __builtin_amdgcn_cvt_scalef32_pk_fp4_f32(p2, b[1].z * sv_, b[1].w * sv_, 1.0f, 3);
  p3 = __builtin_amdgcn_cvt_scalef32_pk_fp4_f32(p3, b[2].x * sv_, b[2].y * sv_, 1.0f, 0);
  p3 = __builtin_amdgcn_cvt_scalef32_pk_fp4_f32(p3, b[2].z * sv_, b[2].w * sv_, 1.0f, 1);
  p3 = __builtin_amdgcn_cvt_scalef32_pk_fp4_f32(p3, b[3].x * sv_, b[3].y * sv_, 1.0f, 2);
  p3 = __builtin_amdgcn_cvt_scalef32_pk_fp4_f32(p3, b[3].z * sv_, b[3].w * sv_, 1.0f, 3);
  *(uint4*)(dst + (size_t)row * 1024 + lane * 16) = make_uint4(p0, p1, p2, p3);
  if (lane == 0) { usc[row] = (mu > 0.f) ? mu / 6.f : 1.f; vsc[row] = (mv > 0.f) ? mv / 6.f : 1.f; }
}

__device__ __forceinline__ void phase_prep(const Params& p, float* sm) {
  const int T_PER_L = 576 + 256 + 512 + 16 + 16;
  const int N_T = 2 * T_PER_L;
  const int N_M = 192;
  const int N_S = 16 + 1 + 1;
  const int N_E = 64 + 8192;
  const int total = N_M + N_T + N_S + N_E;
  for (int it = blockIdx.x; it < total; it += gridDim.x) {
    int item = it;
    if (item < N_M) {
      mod_item(p, item, sm);
      asm volatile("s_waitcnt vmcnt(0)" ::: "memory");
      __syncthreads();
      if (otid() == 0) {
        __builtin_amdgcn_fence(__ATOMIC_RELEASE, "agent");
        asm volatile("s_waitcnt vmcnt(0)" ::: "memory");
        __hip_atomic_fetch_add((int*)(p.ws + OFF_BAR + 15360), 1, __ATOMIC_RELAXED, __HIP_MEMORY_SCOPE_AGENT);
      }
      continue;
    }
    item -= N_M;
    if (item < N_T) {
      int l = item / T_PER_L, r = item % T_PER_L;
      if (r < 576) {
        transpose_convert_tile(p.in[8] + (size_t)l * 1024 * 2304, 1024, 2304, (u16*)(p.ws + OFF_WINT) + (size_t)l * 2304 * HLD, HLD, (r / 36) * 64, (r % 36) * 64, sm);
      } else if (r < 832) {
        r -= 576;
        transpose_convert_tile(p.in[9] + (size_t)l * 1024 * 1024, 1024, 1024, (u16*)(p.ws + OFF_WOUTT) + (size_t)l * 1024 * HLD, HLD, (r / 16) * 64, (r % 16) * 64, sm);
      } else if (r < 1344) {
        r -= 832;
        transpose_convert_tile(p.in[30] + (size_t)l * 1024 * 2048, 1024, 2048, (u16*)(p.ws + OFF_WQT) + (size_t)l * 2048 * HLD, HLD, (r / 32) * 64, (r % 32) * 64, sm);
      } else if (r < 1360) {
        r -= 1344;
        transpose_convert_tile(p.in[23] + (size_t)l * 256 * 256, 256, 256, (u16*)(p.ws + OFF_WGLUT) + (size_t)l * 256 * 256, 256, (r / 4) * 64, (r % 4) * 64, sm);
      } else {
        r -= 1360;
        transpose_convert_tile(p.in[28] + (size_t)l * 256 * 256, 256, 256, (u16*)(p.ws + OFF_WPWT) + (size_t)l * 256 * 256, 256, (r / 4) * 64, (r % 4) * 64, sm);
      }
      continue;
    }
    item -= N_T;
    if (item < N_S) {
      if (item < 16) s5disc_item(p, item);
      else if (item == 16) {
        float* R = (float*)(p.ws + OFF_ROPE);
        for (int idx = otid(); idx < 1024; idx += NTHREADS) {
          int pos = idx >> 4, f = idx & 15;
          float inv = powf(10000.0f, -(float)(2 * f) / 32.0f);
          float ang = (float)pos * inv;
          R[idx] = cosf(ang); R[1024 + idx] = sinf(ang);
        }
      } else {
        if (otid() < 64) ((int*)(p.ws + OFF_CNT))[otid()] = 0;
      }
      continue;
    }
    item -= N_S;
    if (item < 64) convert_chunk(p.in[31], (u16*)(p.ws + OFF_SUBK), (size_t)item * 8192);
    else fp4_uv_item(p.in[32], p.in[33], (unsigned char*)(p.ws + OFF_UTAB), (float*)(p.ws + OFF_USC), (float*)(p.ws + OFF_VSC), (item - 64) * 4);
  }
}

__device__ __forceinline__ void norm_write(const float4 (&v)[4], float r, const float* gn, const float* mv, int sh_off, int sc_off, u16* hrow, int lane) {
#pragma unroll
  for (int i = 0; i < 4; i++) {
    int idx = i * 256 + lane * 4;
    float4 g = *(const float4*)(gn + idx);
    float4 sc = *(const float4*)(mv + sc_off + idx);
    float4 sh = *(const float4*)(mv + sh_off + idx);
    float h0 = v[i].x * r * g.x * (1.f + sc.x) + sh.x;
    float h1 = v[i].y * r * g.y * (1.f + sc.y) + sh.y;
    float h2 = v[i].z * r * g.z * (1.f + sc.z) + sh.z;
    float h3 = v[i].w * r * g.w * (1.f + sc.w) + sh.w;
    *(uint2*)(hrow + idx) = make_uint2(pack2(h0, h1), pack2(h2, h3));
  }
}

__device__ __forceinline__ void phase_norm(const Params& p, int l, int which, bool lat_only) {
  int lane = otid() & 63;
  int wid = blockIdx.x * 4 + (otid() >> 6);
  int nw = gridDim.x * 4;
  int ntok = lat_only ? NB * LSEQ : NT;
  const float* gn = p.in[which == 0 ? 6 : 7] + (size_t)l * DM;
  for (int t = wid; t < ntok; t += nw) {
    int g = lat_only ? ((t >> 12) * SB + LCTX + (t & 4095)) : t;
    const float* xr = (which == 0) ? res_src(p, l, g) : (const float*)res_dst(p, g);
    float4 v[4];
    float ss = 0.f;
#pragma unroll
    for (int i = 0; i < 4; i++) {
      v[i] = *(const float4*)(xr + i * 256 + lane * 4);
      ss += v[i].x * v[i].x + v[i].y * v[i].y + v[i].z * v[i].z + v[i].w * v[i].w;
    }
    ss = wave_sum(ss);
    float r = rsqrtf(ss * (1.f / 1024.f) + 1e-6f);
    const float* mv = mod_vec(p, l, g);
    norm_write(v, r, gn, mv, which == 0 ? 0 : 3072, which == 0 ? 1024 : 4096, (u16*)(p.ws + OFF_HBUF) + (size_t)g * HLD, lane);
  }
}

#define LDT 72

__device__ __forceinline__ void mma_step(const u16* As, int lda, const u16* Bs, int ldb, int kofs, int wm, int wn, int lane, f32x4 (&acc)[4][4]) {
  bf16x8 af[4], bfr[4];
#pragma unroll
  for (int i = 0; i < 4; i++) af[i] = *(const bf16x8*)(As + (wm * 64 + i * 16 + (lane & 15)) * lda + kofs + (lane >> 4) * 8);
#pragma unroll
  for (int j = 0; j < 4; j++) bfr[j] = *(const bf16x8*)(Bs + (wn * 64 + j * 16 + (lane & 15)) * ldb + kofs + (lane >> 4) * 8);
#pragma unroll
  for (int i = 0; i < 4; i++)
#pragma unroll
    for (int j = 0; j < 4; j++) acc[i][j] = __builtin_amdgcn_mfma_f32_16x16x32_bf16(af[i], bfr[j], acc[i][j], 0, 0, 0);
}

struct S5Src { const u16* ub; const float* yf; const float* yb; const float* d; };

__device__ __forceinline__ float s5_y(const S5Src& s, int g, int k) {
  return s.d[k] * bf2f(s.ub[(size_t)g * 256 + k]) + s.yf[(size_t)g * 256 + k] + s.yb[(size_t)g * 256 + k];
}

template <int AMODE>
__device__ __forceinline__ void gemm_load(const u16* A, int lda, const S5Src& s5, const u16* Bt, int ldb, int m0, int n0, int k0,
                                          int lr, int lk, uint4& ra0, uint4& ra1, uint4& ra2, uint4& ra3,
                                          uint4& rb0, uint4& rb1, uint4& rb2, uint4& rb3) {
  if (AMODE == 0) {
    ra0 = *(const uint4*)(A + (size_t)(m0 + lr) * lda + k0 + lk);
    ra1 = *(const uint4*)(A + (size_t)(m0 + 32 + lr) * lda + k0 + lk);
    ra2 = *(const uint4*)(A + (size_t)(m0 + 64 + lr) * lda + k0 + lk);
    ra3 = *(const uint4*)(A + (size_t)(m0 + 96 + lr) * lda + k0 + lk);
  } else {
    int k = k0 + lk;
    {
      int g = m0 + lr;
      ra0 = make_uint4(pack2(gelu_tanh(s5_y(s5, g, k)), gelu_tanh(s5_y(s5, g, k + 1))), pack2(gelu_tanh(s5_y(s5, g, k + 2)), gelu_tanh(s5_y(s5, g, k + 3))),
                       pack2(gelu_tanh(s5_y(s5, g, k + 4)), gelu_tanh(s5_y(s5, g, k + 5))), pack2(gelu_tanh(s5_y(s5, g, k + 6)), gelu_tanh(s5_y(s5, g, k + 7))));
      g += 32;
      ra1 = make_uint4(pack2(gelu_tanh(s5_y(s5, g, k)), gelu_tanh(s5_y(s5, g, k + 1))), pack2(gelu_tanh(s5_y(s5, g, k + 2)), gelu_tanh(s5_y(s5, g, k + 3))),
                       pack2(gelu_tanh(s5_y(s5, g, k + 4)), gelu_tanh(s5_y(s5, g, k + 5))), pack2(gelu_tanh(s5_y(s5, g, k + 6)), gelu_tanh(s5_y(s5, g, k + 7))));
      g += 32;
      ra2 = make_uint4(pack2(gelu_tanh(s5_y(s5, g, k)), gelu_tanh(s5_y(s5, g, k + 1))), pack2(gelu_tanh(s5_y(s5, g, k + 2)), gelu_tanh(s5_y(s5, g, k + 3))),
                       pack2(gelu_tanh(s5_y(s5, g, k + 4)), gelu_tanh(s5_y(s5, g, k + 5))), pack2(gelu_tanh(s5_y(s5, g, k + 6)), gelu_tanh(s5_y(s5, g, k + 7))));
      g += 32;
      ra3 = make_uint4(pack2(gelu_tanh(s5_y(s5, g, k)), gelu_tanh(s5_y(s5, g, k + 1))), pack2(gelu_tanh(s5_y(s5, g, k + 2)), gelu_tanh(s5_y(s5, g, k + 3))),
                       pack2(gelu_tanh(s5_y(s5, g, k + 4)), gelu_tanh(s5_y(s5, g, k + 5))), pack2(gelu_tanh(s5_y(s5, g, k + 6)), gelu_tanh(s5_y(s5, g, k + 7))));
    }
  }
  rb0 = *(const uint4*)(Bt + (size_t)(n0 + lr) * ldb + k0 + lk);
  rb1 = *(const uint4*)(Bt + (size_t)(n0 + 32 + lr) * ldb + k0 + lk);
  rb2 = *(const uint4*)(Bt + (size_t)(n0 + 64 + lr) * ldb + k0 + lk);
  rb3 = *(const uint4*)(Bt + (size_t)(n0 + 96 + lr) * ldb + k0 + lk);
}

template <int AMODE>
__device__ __forceinline__ void gemm_main(const u16* A, int lda, const S5Src& s5, const u16* Bt, int ldb, int K, int m0, int n0,
                                          f32x4 (&acc)[4][4], u16* As, u16* Bs) {
  (void)Bs;
  int tid = otid(), lane = tid & 63, w = tid >> 6, wm = w >> 1, wn = w & 1;
  int lr = tid >> 3, lk = (tid & 7) * 8;
  u16* buf = As;
  const int BUFSZ = 128 * LDT;
  uint4 ra0, ra1, ra2, ra3, rb0, rb1, rb2, rb3;
  const int nk = K / 64;
  const int klast = K - 64;
  gemm_load<AMODE>(A, lda, s5, Bt, ldb, m0, n0, 0, lr, lk, ra0, ra1, ra2, ra3, rb0, rb1, rb2, rb3);
  __syncthreads();
  {
    u16* Aw = buf; u16* Bw = buf + BUFSZ;
    *(uint4*)(Aw + (lr)*LDT + lk) = ra0; *(uint4*)(Aw + (32 + lr) * LDT + lk) = ra1;
    *(uint4*)(Aw + (64 + lr) * LDT + lk) = ra2; *(uint4*)(Aw + (96 + lr) * LDT + lk) = ra3;
    *(uint4*)(Bw + (lr)*LDT + lk) = rb0; *(uint4*)(Bw + (32 + lr) * LDT + lk) = rb1;
    *(uint4*)(Bw + (64 + lr) * LDT + lk) = rb2; *(uint4*)(Bw + (96 + lr) * LDT + lk) = rb3;
  }
  gemm_load<AMODE>(A, lda, s5, Bt, ldb, m0, n0, (nk > 1) ? 64 : 0, lr, lk, ra0, ra1, ra2, ra3, rb0, rb1, rb2, rb3);
  __syncthreads();
  const int aoff = (wm * 64 + (lane & 15)) * LDT + (lane >> 4) * 8;
  const int boff = (wn * 64 + (lane & 15)) * LDT + (lane >> 4) * 8;
  for (int kt = 0; kt < nk; kt++) {
    const u16* Ar = buf + (kt & 1) * 2 * BUFSZ;
    const u16* Br = Ar + BUFSZ;
    u16* Aw = buf + ((kt & 1) ^ 1) * 2 * BUFSZ;
    u16* Bw = Aw + BUFSZ;
    bf16x8 af0[4], bf0[4], af1[4], bf1[4];
#pragma unroll
    for (int i = 0; i < 4; i++) af0[i] = *(const bf16x8*)(Ar + aoff + i * 16 * LDT);
#pragma unroll
    for (int j = 0; j < 4; j++) bf0[j] = *(const bf16x8*)(Br + boff + j * 16 * LDT);
    __builtin_amdgcn_sched_barrier(0);
#pragma unroll
    for (int i = 0; i < 2; i++)
#pragma unroll
      for (int j = 0; j < 4; j++) acc[i][j] = __builtin_amdgcn_mfma_f32_16x16x32_bf16(af0[i], bf0[j], acc[i][j], 0, 0, 0);
#pragma unroll
    for (int i = 0; i < 4; i++) af1[i] = *(const bf16x8*)(Ar + aoff + i * 16 * LDT + 32);
#pragma unroll
    for (int j = 0; j < 4; j++) bf1[j] = *(const bf16x8*)(Br + boff + j * 16 * LDT + 32);
    __builtin_amdgcn_sched_barrier(0);
#pragma unroll
    for (int i = 2; i < 4; i++)
#pragma unroll
      for (int j = 0; j < 4; j++) acc[i][j] = __builtin_amdgcn_mfma_f32_16x16x32_bf16(af0[i], bf0[j], acc[i][j], 0, 0, 0);
    *(uint4*)(Aw + (lr)*LDT + lk) = ra0; *(uint4*)(Aw + (32 + lr) * LDT + lk) = ra1;
    *(uint4*)(Aw + (64 + lr) * LDT + lk) = ra2; *(uint4*)(Aw + (96 + lr) * LDT + lk) = ra3;
    *(uint4*)(Bw + (lr)*LDT + lk) = rb0; *(uint4*)(Bw + (32 + lr) * LDT + lk) = rb1;
    *(uint4*)(Bw + (64 + lr) * LDT + lk) = rb2; *(uint4*)(Bw + (96 + lr) * LDT + lk) = rb3;
    __builtin_amdgcn_sched_barrier(0);
#pragma unroll
    for (int i = 0; i < 2; i++)
#pragma unroll
      for (int j = 0; j < 4; j++) acc[i][j] = __builtin_amdgcn_mfma_f32_16x16x32_bf16(af1[i], bf1[j], acc[i][j], 0, 0, 0);
    {
      int k2 = (kt + 2) * 64;
      k2 = (k2 > klast) ? klast : k2;
      gemm_load<AMODE>(A, lda, s5, Bt, ldb, m0, n0, k2, lr, lk, ra0, ra1, ra2, ra3, rb0, rb1, rb2, rb3);
    }
    __builtin_amdgcn_sched_barrier(0);
#pragma unroll
    for (int i = 2; i < 4; i++)
#pragma unroll
      for (int j = 0; j < 4; j++) acc[i][j] = __builtin_amdgcn_mfma_f32_16x16x32_bf16(af1[i], bf1[j], acc[i][j], 0, 0, 0);
    __syncthreads();
  }
}

#define TLD 132
__device__ __forceinline__ void stage_acc(const f32x4 (&acc)[4][4], float* T, int wm, int wn, int lane) {
#pragma unroll
  for (int i = 0; i < 4; i++)
#pragma unroll
    for (int j = 0; j < 4; j++)
#pragma unroll
      for (int r = 0; r < 4; r++) T[(wm * 64 + i * 16 + (lane >> 4) * 4 + r) * TLD + wn * 64 + j * 16 + (lane & 15)] = acc[i][j][r];
}
__device__ __forceinline__ uint4 pack8(const float4& a, const float4& b) {
  return make_uint4(pack2(a.x, a.y), pack2(a.z, a.w), pack2(b.x, b.y), pack2(b.z, b.w));
}

__device__ __forceinline__ void phase_inproj(const Params& p, int l, u16* sm, const Loc& lc) {
  const u16* H = (const u16*)(p.ws + OFF_HBUF);
  const u16* Wt = (const u16*)(p.ws + OFF_WINT) + (size_t)l * 2304 * HLD;
  u16* Qb = (u16*)(p.ws + OFF_QB);
  u16* Kb = (u16*)(p.ws + OFF_KB);
  u16* Vt = (u16*)(p.ws + OFF_VT);
  u16* Ub = (u16*)(p.ws + OFF_UB);
  u16* Zb = (u16*)(p.ws + OFF_ZB);
  const float* ropeC = (const float*)(p.ws + OFF_ROPE);
  const float* ropeS = ropeC + 1024;
  int tid = otid(), lane = tid & 63, w = tid >> 6, wm = w >> 1, wn = w & 1;
  S5Src dummy{};
  const int xq = lc.xq, lb = lc.lb, nl = lc.nl;
  for (int j = lb; j < 68 * 9; j += nl) {
    int mt = (xq >> 1) * 68 + j / 9, nt = (xq & 1) * 9 + j % 9;
    int m0 = mt * 128, n0 = nt * 128;
    if (l == 1 && (m0 % SB) < LCTX && (nt < 4 || nt >= 14)) continue;
    f32x4 acc[4][4];
#pragma unroll
    for (int i = 0; i < 4; i++)
#pragma unroll
      for (int j = 0; j < 4; j++) acc[i][j] = f32x4{0.f, 0.f, 0.f, 0.f};
    gemm_main<0>(H, HLD, dummy, Wt, HLD, DM, m0, n0, acc, sm, sm + 128 * LDT);
#ifdef PROBE_MAINLOOP2
    gemm_main<0>(H, HLD, dummy, Wt, HLD, DM, m0, n0, acc, sm, sm + 128 * LDT);
#pragma unroll
    for (int i = 0; i < 4; i++)
#pragma unroll
      for (int j = 0; j < 4; j++) acc[i][j] *= 0.5f;
#endif
    int b = m0 / SB, s0 = m0 - b * SB;
    bool is_ctx = s0 < LCTX;
    float* T = (float*)sm;
    if (nt >= 8 && nt < 12) {
      int f = lane & 15, qd = lane >> 4;
#pragma unroll
      for (int i = 0; i < 4; i++)
#pragma unroll
        for (int j = 0; j < 4; j++) {
          int dv = wn * 64 + j * 16 + f;
          int tk = wm * 64 + i * 16 + (((qd & 1) << 1) | (qd >> 1)) * 4;
          *(float4*)(T + dv * TLD + tk) = make_float4(acc[i][j][0], acc[i][j][1], acc[i][j][2], acc[i][j][3]);
        }
    } else {
      stage_acc(acc, T, wm, wn, lane);
    }
    __syncthreads();
    if (nt < 8) {
      int head = nt & 3;
      unsigned char* dstb = (unsigned char*)(nt < 4 ? Qb : Kb) + ((size_t)((b * 4 + head) * 2) * SB) * 64;
      float scale = (nt < 4) ? (0.125f * 1.4426950408889634f) : 1.f;
#pragma unroll
      for (int ps = 0; ps < 8; ps++) {
        int idx = ps * 256 + tid;
        int row = idx >> 4, c8 = (idx & 15) * 8;
        int map = c8 >> 6, d0 = c8 & 63;
        int s = s0 + row;
        float4 o0 = *(const float4*)(T + row * TLD + c8), o1 = *(const float4*)(T + row * TLD + c8 + 4);
        if (!is_ctx) {
          int pd = (d0 & 16) ? -16 : 16;
          float sgn = (d0 & 16) ? 1.f : -1.f;
          float4 p0 = *(const float4*)(T + row * TLD + c8 + pd), p1 = *(const float4*)(T + row * TLD + c8 + pd + 4);
          int t = s - LCTX;
          int pos = (d0 < 32) ? (t >> 6) : (t & 63);
          int f0 = d0 & 15;
          float4 c0 = *(const float4*)(ropeC + pos * 16 + f0), c1 = *(const float4*)(ropeC + pos * 16 + f0 + 4);
          float4 s0v = *(const float4*)(ropeS + pos * 16 + f0), s1v = *(const float4*)(ropeS + pos * 16 + f0 + 4);
          o0 = make_float4(o0.x * c0.x + sgn * p0.x * s0v.x, o0.y * c0.y + sgn * p0.y * s0v.y, o0.z * c0.z + sgn * p0.z * s0v.z, o0.w * c0.w + sgn * p0.w * s0v.w);
          o1 = make_float4(o1.x * c1.x + sgn * p1.x * s1v.x, o1.y * c1.y + sgn * p1.y * s1v.y, o1.z * c1.z + sgn * p1.z * s1v.z, o1.w * c1.w + sgn * p1.w * s1v.w);
        }
        o0 = make_float4(o0.x * scale, o0.y * scale, o0.z * scale, o0.w * scale);
        o1 = make_float4(o1.x * scale, o1.y * scale, o1.z * scale, o1.w * scale);
        int q0 = __builtin_amdgcn_cvt_pk_fp8_f32(o0.x, o0.y, 0, false); q0 = __builtin_amdgcn_cvt_pk_fp8_f32(o0.z, o0.w, q0, true);
        int q1 = __builtin_amdgcn_cvt_pk_fp8_f32(o1.x, o1.y, 0, false); q1 = __builtin_amdgcn_cvt_pk_fp8_f32(o1.z, o1.w, q1, true);
        *(uint2*)(dstb + ((size_t)map * SB + s) * 64 + d0) = make_uint2((unsigned)q0, (unsigned)q1);
      }
    } else if (nt < 12) {
      int head = nt - 8;
#pragma unroll
      for (int ps = 0; ps < 8; ps++) {
        int idx = ps * 256 + tid;
        int dv = idx >> 4, t8 = (idx & 15) * 8;
        float4 o0 = *(const float4*)(T + dv * TLD + t8), o1 = *(const float4*)(T + dv * TLD + t8 + 4);
        int q0 = __builtin_amdgcn_cvt_pk_fp8_f32(o0.x, o0.y, 0, false); q0 = __builtin_amdgcn_cvt_pk_fp8_f32(o0.z, o0.w, q0, true);
        int q1 = __builtin_amdgcn_cvt_pk_fp8_f32(o1.x, o1.y, 0, false); q1 = __builtin_amdgcn_cvt_pk_fp8_f32(o1.z, o1.w, q1, true);
        *(uint2*)((unsigned char*)Vt + ((size_t)((b * 4 + head) * 128 + dv)) * SB + s0 + t8) = make_uint2((unsigned)q0, (unsigned)q1);
      }
    } else {
      u16* dst; int ld, cbase;
      if (nt < 14) { dst = Ub; ld = 256; cbase = (nt - 12) * 128; }
      else { dst = Zb; ld = 512; cbase = (nt - 14) * 128; }
#pragma unroll
      for (int ps = 0; ps < 8; ps++) {
        int idx = ps * 256 + tid;
        int row = idx >> 4, c8 = (idx & 15) * 8;
        float4 o0 = *(const float4*)(T + row * TLD + c8), o1 = *(const float4*)(T + row * TLD + c8 + 4);
        *(uint4*)(dst + (size_t)(m0 + row) * ld + cbase + c8) = pack8(o0, o1);
      }
    }
  }
}

__device__ __forceinline__ void phase_s5g(const Params& p, int l, bool lat_only) {
  const u16* Ub = (const u16*)(p.ws + OFF_UB);
  const float* Yf = (const float*)(p.ws + OFF_YF);
  const float* Yb = (const float*)(p.ws + OFF_YB);
  const float* dsk = p.in[22] + (size_t)l * 256;
  u16* G = (u16*)(p.ws + OFF_G);
  int tid = otid();
  int c8 = (tid & 31) * 8;
  float4 d0 = *(const float4*)(dsk + c8), d1 = *(const float4*)(dsk + c8 + 4);
  int rstep = gridDim.x * 8;
  for (int g = blockIdx.x * 8 + (tid >> 5); g < NT; g += rstep) {
    if (lat_only && (g % SB) < LCTX) continue;
    size_t o = (size_t)g * 256 + c8;
    uint4 u = *(const uint4*)(Ub + o);
    float4 a0 = *(const float4*)(Yf + o), a1 = *(const float4*)(Yf + o + 4);
    float4 b0 = *(const float4*)(Yb + o), b1 = *(const float4*)(Yb + o + 4);
    float y0 = gelu_tanh(d0.x * bflo(u.x) + a0.x + b0.x), y1 = gelu_tanh(d0.y * bfhi(u.x) + a0.y + b0.y);
    float y2 = gelu_tanh(d0.z * bflo(u.y) + a0.z + b0.z), y3 = gelu_tanh(d0.w * bfhi(u.y) + a0.w + b0.w);
    float y4 = gelu_tanh(d1.x * bflo(u.z) + a1.x + b1.x), y5 = gelu_tanh(d1.y * bfhi(u.z) + a1.y + b1.y);
    float y6 = gelu_tanh(d1.z * bflo(u.w) + a1.z + b1.z), y7 = gelu_tanh(d1.w * bfhi(u.w) + a1.w + b1.w);
    *(uint4*)(G + o) = make_uint4(pack2(y0, y1), pack2(y2, y3), pack2(y4, y5), pack2(y6, y7));
  }
}

__device__ __forceinline__ void phase_glu_pw(const Params& p, int l, bool lat_only, u16* sm) {
  u16* H = (u16*)(p.ws + OFF_HBUF);
  S5Src s5{(const u16*)(p.ws + OFF_UB), (const float*)(p.ws + OFF_YF), (const float*)(p.ws + OFF_YB), p.in[22] + (size_t)l * 256};
  const u16* Wg = (const u16*)(p.ws + OFF_WGLUT) + (size_t)l * 65536;
  const u16* Wp = (const u16*)(p.ws + OFF_WPWT) + (size_t)l * 65536;
  const u16* CV = (const u16*)(p.ws + OFF_CVIN);
  const u16* Gb = (const u16*)(p.ws + OFF_G);
  const float* bpw = p.in[29] + (size_t)l * 256;
  int tid = otid(), lane = tid & 63, w = tid >> 6, wm = w >> 1, wn = w & 1;
  int f = lane & 15;
  const int ntiles = (NT / 128) * 4;
  for (int it = blockIdx.x; it < ntiles; it += gridDim.x) {
    int mt = it >> 2, sub = it & 3;
    int m0 = mt * 128;
    int s0 = m0 % SB;
    if (lat_only && s0 < LCTX) continue;
    int n0 = (sub & 1) * 128;
    f32x4 acc[4][4];
#pragma unroll
    for (int i = 0; i < 4; i++)
#pragma unroll
      for (int j = 0; j < 4; j++) acc[i][j] = f32x4{0.f, 0.f, 0.f, 0.f};
    if (sub < 2) {
      gemm_main<0>(Gb, 256, s5, Wg, 256, 256, m0, n0, acc, sm, sm + 128 * LDT);
      float* T = (float*)sm;
      stage_acc(acc, T, wm, wn, lane);
      __syncthreads();
#pragma unroll
      for (int ps = 0; ps < 8; ps++) {
        int idx = ps * 256 + tid;
        int row = idx >> 4, c8 = (idx & 15) * 8;
        int g = m0 + row;
        float4 a0 = *(const float4*)(T + row * TLD + c8), a1 = *(const float4*)(T + row * TLD + c8 + 4);
        uint4 gg = *(const uint4*)(Gb + (size_t)g * 256 + n0 + c8);
        float4 o0 = make_float4(bflo(gg.x) * sigmoidf_(a0.x), bfhi(gg.x) * sigmoidf_(a0.y), bflo(gg.y) * sigmoidf_(a0.z), bfhi(gg.y) * sigmoidf_(a0.w));
        float4 o1 = make_float4(bflo(gg.z) * sigmoidf_(a1.x), bfhi(gg.z) * sigmoidf_(a1.y), bflo(gg.w) * sigmoidf_(a1.z), bfhi(gg.w) * sigmoidf_(a1.w));
        *(uint4*)(H + (size_t)g * HLD + 512 + n0 + c8) = pack8(o0, o1);
      }
    } else {
      gemm_main<0>(CV, 256, s5, Wp, 256, 256, m0, n0, acc, sm, sm + 128 * LDT);
      float* T = (float*)sm;
      stage_acc(acc, T, wm, wn, lane);
      __syncthreads();
#pragma unroll
      for (int ps = 0; ps < 8; ps++) {
        int idx = ps * 256 + tid;
        int row = idx >> 4, c8 = (idx & 15) * 8;
        int g = m0 + row;
        float4 a0 = *(const float4*)(T + row * TLD + c8), a1 = *(const float4*)(T + row * TLD + c8 + 4);
        float4 b0 = *(const float4*)(bpw + n0 + c8), b1 = *(const float4*)(bpw + n0 + c8 + 4);
        float4 o0 = make_float4(a0.x + b0.x, a0.y + b0.y, a0.z + b0.z, a0.w + b0.w);
        float4 o1 = make_float4(a1.x + b1.x, a1.y + b1.y, a1.z + b1.z, a1.w + b1.w);
        *(uint4*)(H + (size_t)g * HLD + 768 + n0 + c8) = pack8(o0, o1);
      }
    }
  }
}

__device__ __forceinline__ void phase_outproj(const Params& p, int l, bool lat_only, u16* sm, const Loc& lc) {
  const u16* H = (const u16*)(p.ws + OFF_HBUF);
  const u16* Wt = (const u16*)(p.ws + OFF_WOUTT) + (size_t)l * 1024 * HLD;
  int tid = otid(), lane = tid & 63, w = tid >> 6, wm = w >> 1, wn = w & 1;
  int f = lane & 15;
  S5Src dummy{};
  const int xq = lc.xq, lb = lc.lb, nl = lc.nl;
  for (int j = lb; j < 68 * 4; j += nl) {
    int mt = (xq >> 1) * 68 + (j >> 2), nt = (xq & 1) * 4 + (j & 3);
    int m0 = mt * 128, n0 = nt * 128;
    if (lat_only && (m0 % SB) < LCTX) continue;
    f32x4 acc[4][4];
#pragma unroll
    for (int i = 0; i < 4; i++)
#pragma unroll
      for (int j = 0; j < 4; j++) acc[i][j] = f32x4{0.f, 0.f, 0.f, 0.f};
    gemm_main<0>(H, HLD, dummy, Wt, HLD, DM, m0, n0, acc, sm, sm + 128 * LDT);
    const float* mv = mod_vec(p, l, m0) + 2048;
    float* T = (float*)sm;
    stage_acc(acc, T, wm, wn, lane);
    __syncthreads();
#pragma unroll
    for (int ps = 0; ps < 8; ps++) {
      int idx = ps * 256 + tid;
      int row = idx >> 4, c8 = (idx & 15) * 8;
      int g = m0 + row;
      const float* xs = res_src(p, l, g) + n0 + c8;
      float* xd = res_dst(p, g) + n0 + c8;
      float4 a0 = *(const float4*)(T + row * TLD + c8), a1 = *(const float4*)(T + row * TLD + c8 + 4);
      float4 x0 = *(const float4*)(xs), x1 = *(const float4*)(xs + 4);
      float4 g0 = *(const float4*)(mv + n0 + c8), g1 = *(const float4*)(mv + n0 + c8 + 4);
      *(float4*)(xd) = make_float4(x0.x + g0.x * a0.x, x0.y + g0.y * a0.y, x0.z + g0.z * a0.z, x0.w + g0.w * a0.w);
      *(float4*)(xd + 4) = make_float4(x1.x + g1.x * a1.x, x1.y + g1.y * a1.y, x1.z + g1.z * a1.z, x1.w + g1.w * a1.w);
    }
  }
}

#define CE_DESC(a, b) { float _hi = fmaxf(a, b); float _lo = fminf(a, b); a = _hi; b = _lo; }
__device__ __forceinline__ void sort16_desc(float (&v)[16]) {
#pragma unroll
  for (int k = 2; k <= 16; k <<= 1) {
#pragma unroll
    for (int j = k >> 1; j > 0; j >>= 1) {
#pragma unroll
      for (int i = 0; i < 16; i++) {
        int l = i ^ j;
        if (l > i) {
          if ((i & k) == 0) { CE_DESC(v[i], v[l]) } else { CE_DESC(v[l], v[i]) }
        }
      }
    }
  }
}
__device__ __forceinline__ void merge16_desc(float (&a)[16], const float (&b)[16]) {
#pragma unroll
  for (int i = 0; i < 16; i++) a[i] = fmaxf(a[i], b[15 - i]);
#pragma unroll
  for (int j = 8; j > 0; j >>= 1) {
#pragma unroll
    for (int i = 0; i < 16; i++) {
      if ((i & j) == 0) { CE_DESC(a[i], a[i + j]) }
    }
  }
}

__device__ __forceinline__ void phase_peerq(const Params& p, int l, bool lat_only, u16* sm, const Loc& lc) {
  const u16* H = (const u16*)(p.ws + OFF_HBUF);
  const u16* Wt = (const u16*)(p.ws + OFF_WQT) + (size_t)l * 2048 * HLD;
  const u16* SK = (const u16*)(p.ws + OFF_SUBK) + (size_t)l * 8 * 2 * 128 * 128;
  float* TK = (float*)(p.ws + OFF_QB);
  int tid = otid(), lane = tid & 63, w = tid >> 6, wm = w >> 1, wn = w & 1;
  int f = lane & 15;
  S5Src dummy{};
  const int xq = lc.xq, lb = lc.lb, nl = lc.nl;
  for (int j = lb; j < 136 * 4; j += nl) {
    int mt = (xq >> 2) * 136 + (j >> 2), hm = (xq & 3) * 4 + (j & 3);
    int m0 = mt * 128, n0 = hm * 128;
    if (lat_only && (m0 % SB) < LCTX) continue;
    f32x4 acc[4][4];
#pragma unroll
    for (int i = 0; i < 4; i++)
#pragma unroll
      for (int j = 0; j < 4; j++) acc[i][j] = f32x4{0.f, 0.f, 0.f, 0.f};
    gemm_main<0>(H, HLD, dummy, Wt, HLD, DM, m0, n0, acc, sm, sm + 128 * LDT);
    __syncthreads();
    u16* Qs = sm;
    u16* Ss = sm + 128 * 136;
#pragma unroll
    for (int i = 0; i < 4; i++)
#pragma unroll
      for (int j = 0; j < 4; j++)
#pragma unroll
        for (int r = 0; r < 4; r++) {
          int row = wm * 64 + i * 16 + (lane >> 4) * 4 + r;
          Qs[row * 136 + wn * 64 + j * 16 + f] = f2bf(acc[i][j][r]);
        }
    {
      const u16* src = SK + (size_t)hm * 128 * 128;
#pragma unroll
      for (int ps = 0; ps < 8; ps++) {
        int idx = ps * 256 + tid;
        int row = idx >> 4, seg = (idx & 15) * 8;
        *(uint4*)(Ss + row * 136 + seg) = *(const uint4*)(src + row * 128 + seg);
      }
    }
    __syncthreads();
#pragma unroll
    for (int i = 0; i < 4; i++)
#pragma unroll
      for (int j = 0; j < 4; j++) acc[i][j] = f32x4{0.f, 0.f, 0.f, 0.f};
#pragma unroll
    for (int kk = 0; kk < 4; kk++) mma_step(Qs, 136, Ss, 136, kk * 32, wm, wn, lane, acc);
    __syncthreads();
    float* Sc = (float*)sm;
    float* Lm = (float*)sm + 128 * 132;
#pragma unroll
    for (int i = 0; i < 4; i++)
#pragma unroll
      for (int j = 0; j < 4; j++)
#pragma unroll
        for (int r = 0; r < 4; r++) {
          int row = wm * 64 + i * 16 + (lane >> 4) * 4 + r;
          Sc[row * 132 + wn * 64 + j * 16 + f] = acc[i][j][r];
        }
    __syncthreads();
    int row = tid >> 1, half = tid & 1;
    float top[16];
    {
      float g1[16], g2[16], g3[16];
#pragma unroll
      for (int q = 0; q < 4; q++) {
        float4 x4 = *(const float4*)(Sc + row * 132 + half * 64 + q * 4);
        float4 y4 = *(const float4*)(Sc + row * 132 + half * 64 + 16 + q * 4);
        float4 z4 = *(const float4*)(Sc + row * 132 + half * 64 + 32 + q * 4);
        float4 w4 = *(const float4*)(Sc + row * 132 + half * 64 + 48 + q * 4);
        uint32_t kb = (uint32_t)(half * 64 + q * 4);
        top[q * 4 + 0] = __uint_as_float((__float_as_uint(x4.x) & ~127u) | (kb + 0)); top[q * 4 + 1] = __uint_as_float((__float_as_uint(x4.y) & ~127u) | (kb + 1));
        top[q * 4 + 2] = __uint_as_float((__float_as_uint(x4.z) & ~127u) | (kb + 2)); top[q * 4 + 3] = __uint_as_float((__float_as_uint(x4.w) & ~127u) | (kb + 3));
        g1[q * 4 + 0] = __uint_as_float((__float_as_uint(y4.x) & ~127u) | (kb + 16)); g1[q * 4 + 1] = __uint_as_float((__float_as_uint(y4.y) & ~127u) | (kb + 17));
        g1[q * 4 + 2] = __uint_as_float((__float_as_uint(y4.z) & ~127u) | (kb + 18)); g1[q * 4 + 3] = __uint_as_float((__float_as_uint(y4.w) & ~127u) | (kb + 19));
        g2[q * 4 + 0] = __uint_as_float((__float_as_uint(z4.x) & ~127u) | (kb + 32)); g2[q * 4 + 1] = __uint_as_float((__float_as_uint(z4.y) & ~127u) | (kb + 33));
        g2[q * 4 + 2] = __uint_as_float((__float_as_uint(z4.z) & ~127u) | (kb + 34)); g2[q * 4 + 3] = __uint_as_float((__float_as_uint(z4.w) & ~127u) | (kb + 35));
        g3[q * 4 + 0] = __uint_as_float((__float_as_uint(w4.x) & ~127u) | (kb + 48)); g3[q * 4 + 1] = __uint_as_float((__float_as_uint(w4.y) & ~127u) | (kb + 49));
        g3[q * 4 + 2] = __uint_as_float((__float_as_uint(w4.z) & ~127u) | (kb + 50)); g3[q * 4 + 3] = __uint_as_float((__float_as_uint(w4.w) & ~127u) | (kb + 51));
      }
      sort16_desc(top); sort16_desc(g1); sort16_desc(g2); sort16_desc(g3);
      merge16_desc(top, g1);
      merge16_desc(g2, g3);
      merge16_desc(top, g2);
    }
    if (half == 1) {
#pragma unroll
      for (int q = 0; q < 4; q++) *(float4*)(Lm + row * 16 + q * 4) = make_float4(top[q * 4], top[q * 4 + 1], top[q * 4 + 2], top[q * 4 + 3]);
    }
    __syncthreads();
    if (half == 0) {
      float o[16];
#pragma unroll
      for (int q = 0; q < 4; q++) {
        float4 t4 = *(const float4*)(Lm + row * 16 + q * 4);
        o[q * 4] = t4.x; o[q * 4 + 1] = t4.y; o[q * 4 + 2] = t4.z; o[q * 4 + 3] = t4.w;
      }
      merge16_desc(top, o);
      float4* d = (float4*)(TK + ((size_t)(m0 + row) * 16 + hm) * 16);
      d[0] = make_float4(top[0], top[1], top[2], top[3]);
      d[1] = make_float4(top[4], top[5], top[6], top[7]);
      d[2] = make_float4(top[8], top[9], top[10], top[11]);
      d[3] = make_float4(top[12], top[13], top[14], top[15]);
    }
    __syncthreads();
  }
}

__device__ __forceinline__ void attn_item(const Params& p, int l, int item, char* smc) {
  int b = item / (4 * 68), rem = item % (4 * 68);
  int h = rem / 68, qb = rem % 68;
  int nkeys = (qb < 4) ? LCTX : SB;
  int s0 = qb * 64;
  int tid = otid(), lane = tid & 63, w = tid >> 6;
  int m = w & 1, qg = w >> 1;
  int r = lane & 31, hh = lane >> 5;
  u16* sm = (u16*)smc;
  unsigned char* Ks = (unsigned char*)smc;
  unsigned char* Vs = (unsigned char*)smc + 2 * 128 * 80;
  unsigned char* Qs = (unsigned char*)smc + 2 * 128 * 80 + 128 * 144;
  float* X = (float*)smc;
  const unsigned char* Qg = (const unsigned char*)(p.ws + OFF_QB) + ((size_t)(b * 4 + h) * 2) * SB * 64;
  const unsigned char* Kg = (const unsigned char*)(p.ws + OFF_KB) + ((size_t)(b * 4 + h) * 2) * SB * 64;
  const unsigned char* Vg = (const unsigned char*)(p.ws + OFF_VT) + ((size_t)(b * 4 + h) * 128) * SB;
  float lam_init = 0.8f - 0.6f * expf(-0.3f * (float)l);
  float lam;
  {
    int oz = opaque_zero();
    float a = p.in[10][l * 64 + lane + oz] * p.in[11][l * 64 + lane + oz];
    float c = p.in[12][l * 64 + lane + oz] * p.in[13][l * 64 + lane + oz];
    a = wave_sum(a); c = wave_sum(c);
    lam = expf(a) - expf(c) + lam_init;
  }
  __syncthreads();
#pragma unroll
  for (int ps = 0; ps < 2; ps++) {
    int idx = ps * 256 + tid;
    int mm = idx >> 8, row = (idx >> 2) & 63, seg = (idx & 3) * 16;
    *(uint4*)(Qs + (mm * 64 + row) * 80 + seg) = *(const uint4*)(Qg + ((size_t)mm * SB + s0 + row) * 64 + seg);
  }
  __syncthreads();
  long qfr[4];
#pragma unroll
  for (int ks = 0; ks < 4; ks++) qfr[ks] = *(const long*)(Qs + (m * 64 + qg * 32 + r) * 80 + ks * 16 + hh * 8);
  f32x16 O[4];
#pragma unroll
  for (int dt = 0; dt < 4; dt++)
#pragma unroll
    for (int i = 0; i < 16; i++) O[dt][i] = 0.f;
  float mrun = 0.f, lrun = 0.f;
  const int st_seg = (tid & 3) * 16;
  const int st_row = tid >> 2;
  const int sv_seg = (tid & 7) * 16;
  const int sv_row = tid >> 3;
  const int nstep = nkeys >> 7;
  uint4 kr0, kr1, kr2, kr3, vr0, vr1, vr2, vr3;
#define ATT_LOADK(KN)                                                                   \
  kr0 = *(const uint4*)(Kg + ((size_t)0 * SB + (KN) + st_row) * 64 + st_seg);           \
  kr1 = *(const uint4*)(Kg + ((size_t)0 * SB + (KN) + 64 + st_row) * 64 + st_seg);      \
  kr2 = *(const uint4*)(Kg + ((size_t)1 * SB + (KN) + st_row) * 64 + st_seg);           \
  kr3 = *(const uint4*)(Kg + ((size_t)1 * SB + (KN) + 64 + st_row) * 64 + st_seg);
#define ATT_LOADV(KN)                                                                   \
  vr0 = *(const uint4*)(Vg + (size_t)(sv_row)*SB + (KN) + sv_seg);                      \
  vr1 = *(const uint4*)(Vg + (size_t)(32 + sv_row) * SB + (KN) + sv_seg);               \
  vr2 = *(const uint4*)(Vg + (size_t)(64 + sv_row) * SB + (KN) + sv_seg);               \
  vr3 = *(const uint4*)(Vg + (size_t)(96 + sv_row) * SB + (KN) + sv_seg);
#define ATT_WRITEK()                                                                    \
  *(uint4*)(Ks + (0 * 128 + st_row) * 80 + st_seg) = kr0;                               \
  *(uint4*)(Ks + (0 * 128 + 64 + st_row) * 80 + st_seg) = kr1;                          \
  *(uint4*)(Ks + (1 * 128 + st_row) * 80 + st_seg) = kr2;                               \
  *(uint4*)(Ks + (1 * 128 + 64 + st_row) * 80 + st_seg) = kr3;
#define ATT_WRITEV()                                                                    \
  *(uint4*)(Vs + (sv_row)*144 + sv_seg) = vr0;                                          \
  *(uint4*)(Vs + (32 + sv_row) * 144 + sv_seg) = vr1;                                   \
  *(uint4*)(Vs + (64 + sv_row) * 144 + sv_seg) = vr2;                                   \
  *(uint4*)(Vs + (96 + sv_row) * 144 + sv_seg) = vr3;
  ATT_LOADK(0)
  ATT_LOADV(0)
  for (int t = 0; t < nstep; t++) {
    __syncthreads();
    ATT_WRITEK()
    ATT_WRITEV()
    __syncthreads();
    if (t + 1 < nstep) { int kn = (t + 1) * 128; ATT_LOADK(kn) ATT_LOADV(kn) }
    __builtin_amdgcn_sched_barrier(0);
#pragma unroll
    for (int sub = 0; sub < 2; sub++) {
      const bool first = (sub == 0) && (t == 0);
      f32x16 sa, sb;
      {
        float ninit = first ? 0.f : -mrun;
#pragma unroll
        for (int i = 0; i < 16; i++) { sa[i] = ninit; sb[i] = ninit; }
      }
#pragma unroll
      for (int ks = 0; ks < 4; ks++) {
        long k0f = *(const long*)(Ks + (m * 128 + sub * 64 + r) * 80 + ks * 16 + hh * 8);
        long k1f = *(const long*)(Ks + (m * 128 + sub * 64 + 32 + r) * 80 + ks * 16 + hh * 8);
        sa = __builtin_amdgcn_mfma_f32_32x32x16_fp8_fp8(k0f, qfr[ks], sa, 0, 0, 0);
        sb = __builtin_amdgcn_mfma_f32_32x32x16_fp8_fp8(k1f, qfr[ks], sb, 0, 0, 0);
      }
      float mx = sa[0];
#pragma unroll
      for (int i = 1; i < 16; i++) mx = fmaxf(mx, sa[i]);
#pragma unroll
      for (int i = 0; i < 16; i++) mx = fmaxf(mx, sb[i]);
      {
        auto pr_ = __builtin_amdgcn_permlane32_swap(__float_as_uint(mx), __float_as_uint(mx), false, false);
        mx = fmaxf(__uint_as_float(pr_[0]), __uint_as_float(pr_[1]));
      }
      if (first) {
        mrun = mx;
#pragma unroll
        for (int i = 0; i < 16; i++) { sa[i] -= mx; sb[i] -= mx; }
      } else if (__any(mx > 8.f)) {
        float dlt = fmaxf(mx, 0.f);
        float alpha = __builtin_amdgcn_exp2f(-dlt);
        mrun += dlt;
        lrun *= alpha;
#pragma unroll
        for (int i = 0; i < 16; i++) { sa[i] -= dlt; sb[i] -= dlt; }
#pragma unroll
        for (int dt = 0; dt < 4; dt++)
#pragma unroll
          for (int i = 0; i < 16; i++) O[dt][i] *= alpha;
      }
      float ls = 0.f;
#pragma unroll
      for (int i = 0; i < 16; i++) { sa[i] = __builtin_amdgcn_exp2f(sa[i]); ls += sa[i]; }
#pragma unroll
      for (int i = 0; i < 16; i++) { sb[i] = __builtin_amdgcn_exp2f(sb[i]); ls += sb[i]; }
      lrun += ls;
      long pf[2][2];
#pragma unroll
      for (int s = 0; s < 2; s++) {
        int a0_ = __builtin_amdgcn_cvt_pk_fp8_f32(sa[8 * s + 0], sa[8 * s + 1], 0, false); a0_ = __builtin_amdgcn_cvt_pk_fp8_f32(sa[8 * s + 2], sa[8 * s + 3], a0_, true);
        int a1_ = __builtin_amdgcn_cvt_pk_fp8_f32(sa[8 * s + 4], sa[8 * s + 5], 0, false); a1_ = __builtin_amdgcn_cvt_pk_fp8_f32(sa[8 * s + 6], sa[8 * s + 7], a1_, true);
        int b0_ = __builtin_amdgcn_cvt_pk_fp8_f32(sb[8 * s + 0], sb[8 * s + 1], 0, false); b0_ = __builtin_amdgcn_cvt_pk_fp8_f32(sb[8 * s + 2], sb[8 * s + 3], b0_, true);
        int b1_ = __builtin_amdgcn_cvt_pk_fp8_f32(sb[8 * s + 4], sb[8 * s + 5], 0, false); b1_ = __builtin_amdgcn_cvt_pk_fp8_f32(sb[8 * s + 6], sb[8 * s + 7], b1_, true);
        pf[0][s] = (long)(((unsigned long)(unsigned)a1_ << 32) | (unsigned long)(unsigned)a0_);
        pf[1][s] = (long)(((unsigned long)(unsigned)b1_ << 32) | (unsigned long)(unsigned)b0_);
      }
#pragma unroll
      for (int kt = 0; kt < 2; kt++)
#pragma unroll
        for (int s = 0; s < 2; s++)
#pragma unroll
          for (int dt = 0; dt < 4; dt++) {
            long vf = *(const long*)(Vs + (dt * 32 + r) * 144 + sub * 64 + kt * 32 + s * 16 + hh * 8);
            O[dt] = __builtin_amdgcn_mfma_f32_32x32x16_fp8_fp8(vf, pf[kt][s], O[dt], 0, 0, 0);
          }
    }
  }
#undef ATT_LOADK
#undef ATT_LOADV
#undef ATT_WRITEK
#undef ATT_WRITEV
  float ltot = lrun + __shfl_xor(lrun, 32);
  __syncthreads();
  if (m == 1) {
    float sc = lam / ltot;
#pragma unroll
    for (int dt = 0; dt < 4; dt++)
#pragma unroll
      for (int i = 0; i < 16; i++) X[(qg * 64 + dt * 16 + i) * 64 + lane] = O[dt][i] * sc;
  }
  __syncthreads();
  if (m == 0) {
    float i0 = 1.f / ltot;
    float ss = 0.f;
#pragma unroll
    for (int dt = 0; dt < 4; dt++)
#pragma unroll
      for (int i = 0; i < 16; i++) {
        float o = O[dt][i] * i0 - X[(qg * 64 + dt * 16 + i) * 64 + lane];
        O[dt][i] = o;
        ss += o * o;
      }
    ss += __shfl_xor(ss, 32);
    float rr = rsqrtf(ss * (1.f / 128.f) + 1e-6f) * (1.f - lam_init);
    const float* sg = p.in[14] + (size_t)l * 128 + opaque_zero();
    int g = b * SB + s0 + qg * 32 + r;
    u16* dst = (u16*)(p.ws + OFF_HBUF) + (size_t)g * HLD + h * 128;
#pragma unroll
    for (int dt = 0; dt < 4; dt++)
#pragma unroll
      for (int q4 = 0; q4 < 4; q4++) {
        int dv = dt * 32 + 8 * q4 + 4 * hh;
        float4 gg = *(const float4*)(sg + dv);
        *(uint2*)(dst + dv) = make_uint2(pack2(O[dt][q4 * 4 + 0] * rr * gg.x, O[dt][q4 * 4 + 1] * rr * gg.y),
                                         pack2(O[dt][q4 * 4 + 2] * rr * gg.z, O[dt][q4 * 4 + 3] * rr * gg.w));
      }
  }
}

__device__ __forceinline__ void s5_item(const Params& p, int l, int item, float* sm) {
  int b = item >> 5, dir = (item >> 4) & 1, g = item & 15;
  int pidx = ((l * 2 + dir) * 16 + g) * 64;
  const float* Aw = (const float*)(p.ws + OFF_S5A);
  const float* BB = (const float*)(p.ws + OFF_S5BB);
  const float* cre = p.in[20] + (size_t)((l * 2 + dir) * 16 + g) * 16 * 64;
  const float* cim = p.in[21] + (size_t)((l * 2 + dir) * 16 + g) * 16 * 64;
  const u16* Ub = (const u16*)(p.ws + OFF_UB);
  float* Y = (float*)(p.ws + (dir ? OFF_YB : OFF_YF));
  float* Hr = sm;
  float* Hi = sm + 4352;
  float* Er = sm + 8704;
  float* Ei = Er + 256;
  float* Cc = Er + 512;
  u16* Hb = (u16*)(sm + 8704 + 768);
  int tid = otid(), lane = tid & 63, w = tid >> 6;
  int pp = tid & 63, sub = w;
  int r = lane & 31, hh = lane >> 5;
  float a_r = Aw[pidx + pp], a_i = Aw[4096 + pidx + pp];
  float a16r = a_r, a16i = a_i;
#pragma unroll
  for (int k = 0; k < 4; k++) { float nr = a16r * a16r - a16i * a16i; float ni = 2.f * a16r * a16i; a16r = nr; a16i = ni; }
  bf16x8 bfrag;
  {
    const float* s = BB + (w >= 2 ? 65536 : 0) + (size_t)(pidx + (w & 1) * 32 + r) * 16 + 8 * hh;
    float4 x0 = *(const float4*)s, x1 = *(const float4*)(s + 4);
    uint4 u = make_uint4(pack2(x0.x, x0.y), pack2(x0.z, x0.w), pack2(x1.x, x1.y), pack2(x1.z, x1.w));
    bfrag = __builtin_bit_cast(bf16x8, u);
  }
  bf16x8 cf[4];
  {
    int hcol = lane & 15, kq = lane >> 4;
#pragma unroll
    for (int ks = 0; ks < 4; ks++) {
      int kb = ks * 32 + kq * 8;
      const float* s = (kb < 64) ? (cre + hcol * 64 + kb) : (cim + hcol * 64 + kb - 64);
      float sg = (kb < 64) ? 1.f : -1.f;
      float4 x0 = *(const float4*)s, x1 = *(const float4*)(s + 4);
      uint4 u = make_uint4(pack2(sg * x0.x, sg * x0.y), pack2(sg * x0.z, sg * x0.w), pack2(sg * x1.x, sg * x1.y), pack2(sg * x1.z, sg * x1.w));
      cf[ks] = __builtin_bit_cast(bf16x8, u);
    }
  }
  __syncthreads();
  if (tid < 128) Cc[tid] = 0.f;
  const int sstep = (dir == 0) ? 1 : -1;
  uint4 ua0, ua1;
  {
    int sbase = (dir == 0) ? 0 : 255;
    ua0 = *(const uint4*)(Ub + ((size_t)(b * SB + sbase + sstep * r)) * 256 + g * 16 + 8 * hh);
    ua1 = *(const uint4*)(Ub + ((size_t)(b * SB + sbase + sstep * (32 + r))) * 256 + g * 16 + 8 * hh);
  }
  for (int c = 0; c < 68; c++) {
    int i0 = c * 64;
    int sbase = (dir == 0) ? i0 : (i0 < 256 ? 255 - i0 : 4607 - i0);
    {
      f32x16 z;
#pragma unroll
      for (int i = 0; i < 16; i++) z[i] = 0.f;
      f32x16 d0 = __builtin_amdgcn_mfma_f32_32x32x16_bf16(__builtin_bit_cast(bf16x8, ua0), bfrag, z, 0, 0, 0);
      f32x16 d1 = __builtin_amdgcn_mfma_f32_32x32x16_bf16(__builtin_bit_cast(bf16x8, ua1), bfrag, z, 0, 0, 0);
      float* Hx = (w >= 2) ? Hi : Hr;
      int pcol = (w & 1) * 32 + r;
#pragma unroll
      for (int i = 0; i < 16; i++) {
        int row = (i & 3) + 8 * (i >> 2) + 4 * hh;
        Hx[row * 68 + pcol] = d0[i];
        Hx[(32 + row) * 68 + pcol] = d1[i];
      }
    }
    if (c + 1 < 68) {
      int i1 = i0 + 64;
      int sb1 = (dir == 0) ? i1 : (i1 < 256 ? 255 - i1 : 4607 - i1);
      ua0 = *(const uint4*)(Ub + ((size_t)(b * SB + sb1 + sstep * r)) * 256 + g * 16 + 8 * hh);
      ua1 = *(const uint4*)(Ub + ((size_t)(b * SB + sb1 + sstep * (32 + r))) * 256 + g * 16 + 8 * hh);
    }
    __syncthreads();
    float lr[16], li[16];
    {
      float er = 0.f, ei = 0.f;
#pragma unroll
      for (int t = 0; t < 16; t++) {
        float xr = Hr[(sub * 16 + t) * 68 + pp], xi = Hi[(sub * 16 + t) * 68 + pp];
        float nr = a_r * er - a_i * ei + xr;
        float ni = a_r * ei + a_i * er + xi;
        er = nr; ei = ni;
        lr[t] = er; li[t] = ei;
      }
      Er[sub * 64 + pp] = er; Ei[sub * 64 + pp] = ei;
    }
    __syncthreads();
    {
      float sr = Cc[(c & 1) * 128 + pp], si = Cc[(c & 1) * 128 + 64 + pp];
      for (int j = 0; j < sub; j++) {
        float e_r = Er[j * 64 + pp], e_i = Ei[j * 64 + pp];
        float nr = a16r * sr - a16i * si + e_r;
        float ni = a16r * si + a16i * sr + e_i;
        sr = nr; si = ni;
      }
      float pr = a_r, pi = a_i;
      float last_r = 0.f, last_i = 0.f;
#pragma unroll
      for (int t = 0; t < 16; t++) {
        float hr = lr[t] + pr * sr - pi * si;
        float hi = li[t] + pr * si + pi * sr;
        Hb[(sub * 16 + t) * 136 + pp] = f2bf(hr);
        Hb[(sub * 16 + t) * 136 + 64 + pp] = f2bf(hi);
        last_r = hr; last_i = hi;
        float npr = pr * a_r - pi * a_i;
        float npi = pr * a_i + pi * a_r;
        pr = npr; pi = npi;
      }
      if (sub == 3) { Cc[((c + 1) & 1) * 128 + pp] = last_r; Cc[((c + 1) & 1) * 128 + 64 + pp] = last_i; }
    }
    {
      f32x4 acc = f32x4{0.f, 0.f, 0.f, 0.f};
#pragma unroll
      for (int ks = 0; ks < 4; ks++) {
        bf16x8 af = *(const bf16x8*)(Hb + (w * 16 + (lane & 15)) * 136 + ks * 32 + (lane >> 4) * 8);
        acc = __builtin_amdgcn_mfma_f32_16x16x32_bf16(af, cf[ks], acc, 0, 0, 0);
      }
#pragma unroll
      for (int rr = 0; rr < 4; rr++) {
        int tok = w * 16 + (lane >> 4) * 4 + rr;
        int s = sbase + sstep * tok;
        Y[((size_t)(b * SB + s)) * 256 + g * 16 + (lane & 15)] = acc[rr];
      }
    }
  }
}

__device__ __forceinline__ void conv_item(const Params& p, int l, int item, char* smc) {
  int g0 = item * 32;
  int b = g0 / SB, s0 = g0 - b * SB;
  int seg_lo = (s0 < LCTX) ? 0 : LCTX, seg_hi = (s0 < LCTX) ? LCTX : SB;
  const u16* Zb = (const u16*)(p.ws + OFF_ZB);
  u16* hg = (u16*)smc;
  float* co = (float*)(smc + 62 * 256 * 2);
  int tid = otid(), lane = tid & 63, w = tid >> 6;
  __syncthreads();
  for (int idx = tid; idx < 62 * 32; idx += NTHREADS) {
    int rr = idx >> 5, c8 = (idx & 31) * 8;
    int s = s0 - 15 + rr;
    uint4 o = make_uint4(0, 0, 0, 0);
    if (s >= seg_lo && s < seg_hi) {
      const u16* zr = Zb + ((size_t)(b * SB + s)) * 512;
      uint4 a = *(const uint4*)(zr + c8), gt = *(const uint4*)(zr + 256 + c8);
      o.x = pack2(bflo(a.x) * sigmoidf_(bflo(gt.x)), bfhi(a.x) * sigmoidf_(bfhi(gt.x)));
      o.y = pack2(bflo(a.y) * sigmoidf_(bflo(gt.y)), bfhi(a.y) * sigmoidf_(bfhi(gt.y)));
      o.z = pack2(bflo(a.z) * sigmoidf_(bflo(gt.z)), bfhi(a.z) * sigmoidf_(bfhi(gt.z)));
      o.w = pack2(bflo(a.w) * sigmoidf_(bflo(gt.w)), bfhi(a.w) * sigmoidf_(bfhi(gt.w)));
    }
    *(uint4*)(hg + rr * 256 + c8) = o;
  }
  __syncthreads();
  {
    int c = tid;
    const float* wd = p.in[24] + (size_t)l * 31 * 256 + opaque_zero();
    float wv[31];
#pragma unroll
    for (int j = 0; j < 31; j++) wv[j] = wd[j * 256 + c];
    float bd = p.in[25][l * 256 + c + opaque_zero()];
#pragma unroll 2
    for (int t = 0; t < 32; t++) {
      float acc = bd;
#pragma unroll
      for (int j = 0; j < 31; j++) acc += wv[j] * bf2f(hg[(t + j) * 256 + c]);
      co[t * 256 + c] = acc;
    }
  }
  __syncthreads();
  {
    const float* lg = p.in[26] + (size_t)l * 256 + opaque_zero();
    const float* lb = p.in[27] + (size_t)l * 256 + opaque_zero();
    float4 gg = *(const float4*)(lg + lane * 4), bb = *(const float4*)(lb + lane * 4);
    u16* CV = (u16*)(p.ws + OFF_CVIN);
    for (int tt = 0; tt < 8; tt++) {
      int t = w * 8 + tt;
      float4 v = *(const float4*)(co + t * 256 + lane * 4);
      float sm1 = v.x + v.y + v.z + v.w;
      sm1 = wave_sum(sm1);
      float mean = sm1 * (1.f / 256.f);
      float d0 = v.x - mean, d1 = v.y - mean, d2 = v.z - mean, d3 = v.w - mean;
      float sq = d0 * d0 + d1 * d1 + d2 * d2 + d3 * d3;
      sq = wave_sum(sq);
      float rstd = rsqrtf(sq * (1.f / 256.f) + 1e-6f);
      float y0 = siluf_(d0 * rstd * gg.x + bb.x), y1 = siluf_(d1 * rstd * gg.y + bb.y);
      float y2 = siluf_(d2 * rstd * gg.z + bb.z), y3 = siluf_(d3 * rstd * gg.w + bb.w);
      *(uint2*)(CV + ((size_t)(g0 + t)) * 256 + lane * 4) = make_uint2(pack2(y0, y1), pack2(y2, y3));
    }
  }
}

__device__ __forceinline__ void phase_mix(const Params& p, int l, bool lat_only, char* smc, int cidx, const Loc& lc, int mode = 0) {
  int* cnt = (int*)(p.ws + OFF_CNT) + cidx * 16;
  int* slot = (int*)(smc + SMEM_BYTES - 16);
  const int N_S5 = 256, N_CV = NT / 32;
  if (mode != 1) {
    while (true) {
      __syncthreads();
      if (otid() == 0) *slot = atomicAdd(cnt, 1);
      __syncthreads();
      int item = *slot;
      if (item >= N_S5) break;
      s5_item(p, l, item, (float*)smc);
    }
  }
  if (mode != 2) {
    int xcd = lc.xq;
    for (int rot = 0; rot < 8; rot++) {
      int xq = (xcd + rot) & 7;
      while (true) {
        __syncthreads();
        if (otid() == 0) *slot = atomicAdd(cnt + 1 + xq, 1);
        __syncthreads();
        int j = *slot;
        if (j >= 4 * 68) break;
        int pair = xq + 8 * (j / 68), qb = j % 68;
        if (lat_only && qb < 4) continue;
        attn_item(p, l, pair * 68 + qb, smc);
      }
    }
  }
  if (mode != 1) {
    while (true) {
      __syncthreads();
      if (otid() == 0) *slot = atomicAdd(cnt + 9, 1);
      __syncthreads();
      int item = *slot;
      if (item >= N_CV) break;
      if (lat_only && ((item * 32) % SB) < LCTX) continue;
      conv_item(p, l, item, smc);
    }
  }
}

__device__ __forceinline__ void phase_gather(const Params& p, int l, bool last, char* smc, bool dry = false) {
  int tid = otid(), lane = tid & 63, w = tid >> 6;
  float* selv = (float*)smc + w * 512;
  int* seli = (int*)smc + w * 512 + 128;
  float* selu = (float*)smc + w * 512 + 256;
  const u16* H = (const u16*)(p.ws + OFF_HBUF);
  const float* TK = (const float*)(p.ws + OFF_QB);
  const unsigned char* UT = (const unsigned char*)(p.ws + OFF_UTAB) + (size_t)l * 16384 * 1024;
  const unsigned char* VT = (const unsigned char*)(p.ws + OFF_VTAB) + (size_t)l * 16384 * V_ROWB;
  const float* USC = (const float*)(p.ws + OFF_USC) + (size_t)l * 16384;
  const float* VSC = (const float*)(p.ws + OFF_VSC) + (size_t)l * 16384;
  int ci = 0, cj = 0;
  bool cvalid = lane < 50;
  {
    int rem = lane, i = 0;
    while (i < 16 && rem >= 16 / (i + 1)) { rem -= 16 / (i + 1); i++; }
    ci = i < 16 ? i : 0; cj = i < 16 ? rem : 0;
  }
  const bool b5 = (lane & 32) != 0, b4 = (lane & 16) != 0, b3 = (lane & 8) != 0;
  const int myrow = (b5 ? 4 : 0) + (b4 ? 2 : 0) + (b3 ? 1 : 0);
  int ntok = last ? NB * LSEQ : NT;
  int* tq = (int*)(p.ws + OFF_CNT) + 60 + l;
  while (true) {
    int t = 0;
    if (lane == 0) t = atomicAdd(tq, 1);
    t = __builtin_amdgcn_readfirstlane(t);
    if (t >= ntok) break;
    int g = last ? ((t >> 12) * SB + LCTX + (t & 4095)) : t;
    const u16* hrow = H + (size_t)g * HLD + lane * 16;
    uint4 xa = *(const uint4*)(hrow);
    uint4 xb = *(const uint4*)(hrow + 8);
    f2 x2[8];
    x2[0] = f2{bflo(xa.x), bfhi(xa.x)}; x2[1] = f2{bflo(xa.y), bfhi(xa.y)};
    x2[2] = f2{bflo(xa.z), bfhi(xa.z)}; x2[3] = f2{bflo(xa.w), bfhi(xa.w)};
    x2[4] = f2{bflo(xb.x), bfhi(xb.x)}; x2[5] = f2{bflo(xb.y), bfhi(xb.y)};
    x2[6] = f2{bflo(xb.z), bfhi(xb.z)}; x2[7] = f2{bflo(xb.w), bfhi(xb.w)};
    const float* tk = TK + (size_t)g * 256;
    float tv0[8], tv1[8];
#pragma unroll
    for (int hd = 0; hd < 8; hd++) { tv0[hd] = tk[(hd * 2) * 16 + ci]; tv1[hd] = tk[(hd * 2 + 1) * 16 + cj]; }
#pragma unroll
    for (int hd = 0; hd < 8; hd++) {
      float v0 = tv0[hd], v1 = tv1[hd];
      uint32_t b0 = __float_as_uint(v0), b1 = __float_as_uint(v1);
      float val = cvalid ? (__uint_as_float(b0 & ~127u) + __uint_as_float(b1 & ~127u)) : -3.0e38f;
      val = __uint_as_float((__float_as_uint(val) & ~63u) | (uint32_t)(63 - lane));
      int e = (int)((b0 & 127u) * 128u + (b1 & 127u));
      int rank = 0;
#pragma unroll
      for (int c = 0; c < 50; c++) {
        float vc = __builtin_bit_cast(float, __builtin_amdgcn_readlane(__builtin_bit_cast(int, val), c));
        rank += (vc > val) ? 1 : 0;
      }
      if (cvalid && rank < 16) { selv[hd * 16 + rank] = val; seli[hd * 16 + rank] = e; }
    }
    {
      float a0 = selv[lane], a1 = selv[64 + lane];
      int e0i = seli[lane], e1i = seli[64 + lane];
      float us0 = USC[e0i], us1 = USC[e1i], vs0 = VSC[e0i], vs1 = VSC[e1i];
      float m0 = a0, m1 = a1;
#pragma unroll
      for (int o = 8; o >= 1; o >>= 1) { m0 = fmaxf(m0, __shfl_xor(m0, o)); m1 = fmaxf(m1, __shfl_xor(m1, o)); }
      float e0 = __expf(a0 - m0), e1 = __expf(a1 - m1);
      float s0 = e0, s1 = e1;
#pragma unroll
      for (int o = 8; o >= 1; o >>= 1) { s0 += __shfl_xor(s0, o); s1 += __shfl_xor(s1, o); }
      selv[lane] = e0 / s0 * vs0; selv[64 + lane] = e1 / s1 * vs1;
      selu[lane] = us0; selu[64 + lane] = us1;
    }
    f2 acc2[8];
#pragma unroll
    for (int i = 0; i < 8; i++) acc2[i] = f2{0.f, 0.f};
    URow uA[8], uB[8];
    VRow vA[8], vB[8];
#define GATHER_LOAD(UU, VV, BT)                                                   \
    _Pragma("unroll") for (int q = 0; q < 8; q++) {                               \
      int e = __builtin_amdgcn_readfirstlane(seli[(BT) * 8 + q]);                 \
      uint4 c_ = *(const uint4*)(UT + (size_t)e * 1024 + lane * 16);              \
      UU[q].v = make_uint2(c_.x, c_.y); VV[q].v = make_uint2(c_.z, c_.w);         \
    }
#define GATHER_COMPUTE(UU, VV, BT)                                                \
    {                                                                             \
      float s[8];                                                                 \
      _Pragma("unroll") for (int q = 0; q < 8; q++) {                             \
        f2 du[8]; dec_row(UU[q], du);                                             \
        f2 d2 = du[0] * x2[0];                                                    \
        d2 += du[1] * x2[1]; d2 += du[2] * x2[2]; d2 += du[3] * x2[3];            \
        d2 += du[4] * x2[4]; d2 += du[5] * x2[5]; d2 += du[6] * x2[6]; d2 += du[7] * x2[7]; \
        s[q] = d2[0] + d2[1];                                                     \
      }                                                                           \
      float t4[4];                                                                \
      _Pragma("unroll") for (int i = 0; i < 4; i++) {                             \
        float send = b5 ? s[i] : s[i + 4];                                        \
        float keep = b5 ? s[i + 4] : s[i];                                        \
        t4[i] = keep + __shfl_xor(send, 32);                                      \
      }                                                                           \
      float t2[2];                                                                \
      _Pragma("unroll") for (int i = 0; i < 2; i++) {                             \
        float send = b4 ? t4[i] : t4[i + 2];                                      \
        float keep = b4 ? t4[i + 2] : t4[i];                                      \
        t2[i] = keep + __shfl_xor(send, 16);                                      \
      }                                                                           \
      float tv;                                                                   \
      {                                                                           \
        float send = b3 ? t2[0] : t2[1];                                          \
        float keep = b3 ? t2[1] : t2[0];                                          \
        tv = keep + __shfl_xor(send, 8);                                          \
      }                                                                           \
      tv += __shfl_xor(tv, 4); tv += __shfl_xor(tv, 2); tv += __shfl_xor(tv, 1);  \
      float wmine = selv[(BT) * 8 + myrow] * gelu_tanh(tv * selu[(BT) * 8 + myrow]); \
      _Pragma("unroll") for (int q = 0; q < 8; q++) {                             \
        const int src_lane = ((q >> 2) & 1) * 32 + ((q >> 1) & 1) * 16 + (q & 1) * 8; \
        float wq = __builtin_bit_cast(float, __builtin_amdgcn_readlane(__builtin_bit_cast(int, wmine), src_lane)); \
        f2 wq2 = f2{wq, wq};                                                      \
        f2 dv[8]; dec_row(VV[q], dv);                                             \
        acc2[0] += wq2 * dv[0]; acc2[1] += wq2 * dv[1]; acc2[2] += wq2 * dv[2]; acc2[3] += wq2 * dv[3]; \
        acc2[4] += wq2 * dv[4]; acc2[5] += wq2 * dv[5]; acc2[6] += wq2 * dv[6]; acc2[7] += wq2 * dv[7]; \
      }                                                                           \
    }
    GATHER_LOAD(uA, vA, 0)
    for (int bt = 0; bt < 16; bt += 2) {
      GATHER_LOAD(uB, vB, bt + 1)
      GATHER_COMPUTE(uA, vA, bt)
      if (bt + 2 < 16) { GATHER_LOAD(uA, vA, bt + 2) }
      GATHER_COMPUTE(uB, vB, bt + 1)
    }
#undef GATHER_LOAD
#undef GATHER_COMPUTE
    float acc[16];
#pragma unroll
    for (int i = 0; i < 8; i++) { acc[2 * i] = acc2[i][0]; acc[2 * i + 1] = acc2[i][1]; }
    float* xr = res_dst(p, g) + lane * 16;
    float* xw = dry ? ((float*)(p.ws + OFF_YF) + (size_t)(g & 1023) * 1024 + lane * 16) : xr;
    const float* mv = mod_vec(p, l, g) + lane * 16;
    float xn[16];
    float ss = 0.f;
#pragma unroll
    for (int q4 = 0; q4 < 4; q4++) {
      float4 xo = *(const float4*)(xr + q4 * 4);
      float4 gt = *(const float4*)(mv + 5120 + q4 * 4);
      float n0 = xo.x + gt.x * acc[q4 * 4 + 0];
      float n1 = xo.y + gt.y * acc[q4 * 4 + 1];
      float n2 = xo.z + gt.z * acc[q4 * 4 + 2];
      float n3 = xo.w + gt.w * acc[q4 * 4 + 3];
      xn[q4 * 4 + 0] = n0; xn[q4 * 4 + 1] = n1; xn[q4 * 4 + 2] = n2; xn[q4 * 4 + 3] = n3;
      ss += n0 * n0 + n1 * n1 + n2 * n2 + n3 * n3;
    }
    ss = wave_sum(ss);
    float rn = rsqrtf(ss * (1.f / 1024.f) + 1e-6f);
    if (last) {
      const float* gf = p.in[34] + lane * 16;
#pragma unroll
      for (int q4 = 0; q4 < 4; q4++) {
        float4 gg = *(const float4*)(gf + q4 * 4);
        *(float4*)(xw + q4 * 4) = make_float4(xn[q4 * 4 + 0] * rn * gg.x, xn[q4 * 4 + 1] * rn * gg.y, xn[q4 * 4 + 2] * rn * gg.z, xn[q4 * 4 + 3] * rn * gg.w);
      }
    } else {
      const float* gn = p.in[6] + (size_t)(l + 1) * DM + lane * 16;
      const float* mv2 = mod_vec(p, l + 1, g) + lane * 16;
      u16* hw = dry ? ((u16*)(p.ws + OFF_YB) + (size_t)(g & 1023) * 1024 + lane * 16) : ((u16*)(p.ws + OFF_HBUF) + (size_t)g * HLD + lane * 16);
#pragma unroll
      for (int q4 = 0; q4 < 4; q4++) {
        *(float4*)(xw + q4 * 4) = make_float4(xn[q4 * 4 + 0], xn[q4 * 4 + 1], xn[q4 * 4 + 2], xn[q4 * 4 + 3]);
        float4 gg = *(const float4*)(gn + q4 * 4);
        float4 sc = *(const float4*)(mv2 + 1024 + q4 * 4);
        float4 sh = *(const float4*)(mv2 + q4 * 4);
        float h0 = xn[q4 * 4 + 0] * rn * gg.x * (1.f + sc.x) + sh.x;
        float h1 = xn[q4 * 4 + 1] * rn * gg.y * (1.f + sc.y) + sh.y;
        float h2 = xn[q4 * 4 + 2] * rn * gg.z * (1.f + sc.z) + sh.z;
        float h3 = xn[q4 * 4 + 3] * rn * gg.w * (1.f + sc.w) + sh.w;
        *(uint2*)(hw + q4 * 4) = make_uint2(pack2(h0, h1), pack2(h2, h3));
      }
    }
  }
}

#define XB_TMO      128
#define XB_XCNT(j)  (256  + 64 * (j))
#define XB_XSUB(j)  (1280 + 64 * (j))
#define XB_XGEN(j)  (2304 + 64 * (j))
#define XB_TOP      3328
#define XB_TOPGEN   3392
#define XCD_BAR_WORDS 3456
#define XB_SPIN_CAP (1u << 18)
#define LAS __attribute__((address_space(3)))

__device__ __forceinline__ unsigned xb_ld(unsigned* p)              { return __hip_atomic_load(p, __ATOMIC_RELAXED, __HIP_MEMORY_SCOPE_AGENT); }
__device__ __forceinline__ unsigned xb_add(unsigned* p, unsigned v) { return __hip_atomic_fetch_add(p, v, __ATOMIC_RELAXED, __HIP_MEMORY_SCOPE_AGENT); }
__device__ __forceinline__ unsigned xb_xcc_id() { return (unsigned)__builtin_amdgcn_s_getreg((3 << 11) | 20) & 0xFu; }
#define XB_SPIN(cond, bar) do { unsigned _sp = 0; while (cond) { __builtin_amdgcn_s_sleep(1); \
    if ((++_sp & 255u) == 0u) { if (xb_ld(&(bar)[XB_TMO])) break; if (_sp > XB_SPIN_CAP) { atomicAdd(&(bar)[XB_TMO], 1u); break; } } } } while (0)

struct XcdBarrier {
    unsigned* bar; unsigned x;
    volatile LAS unsigned* st;
};

__device__ __forceinline__ XcdBarrier xcd_barrier_post(unsigned* bar, volatile LAS unsigned* st) {
    XcdBarrier b; b.bar = bar; b.x = xb_xcc_id(); b.st = st;
    if (threadIdx.x == 0) (void)xb_add(&bar[XB_XCNT(b.x)], 1u);
    return b;
}
__device__ __forceinline__ void xcd_barrier_complete(unsigned* bar, unsigned x, unsigned& nloc, unsigned& nx) {
    const unsigned G = gridDim.x * gridDim.y * gridDim.z;
    unsigned sum, cnt, mine, sp = 0u;
    for (;;) {
        sum = 0u; cnt = 0u; mine = 0u;
#pragma unroll
        for (unsigned j = 0; j < 16; ++j) { const unsigned c = xb_ld(&bar[XB_XCNT(j)]); sum += c; cnt += (c > 0u) ? 1u : 0u; mine = (j == x) ? c : mine; }
        if (sum == G) break;
        __builtin_amdgcn_s_sleep(1);
        if ((++sp & 255u) == 0u) { if (xb_ld(&bar[XB_TMO])) break; if (sp > XB_SPIN_CAP) { atomicAdd(&bar[XB_TMO], 1u); break; } }
    }
    nloc = mine > 0u ? mine : 1u; nx = cnt > 0u ? cnt : 1u;
}

__device__ __forceinline__ void xcd_barrier(const XcdBarrier& b) {
    asm volatile("s_waitcnt vmcnt(0)" ::: "memory");
    __syncthreads();
    if (threadIdx.x == 0) {
        unsigned* bar = b.bar;
        __builtin_amdgcn_s_waitcnt(0);
        unsigned nloc = b.st[0], nx = b.st[1];
        if (nloc == 0u) { xcd_barrier_complete(bar, b.x, nloc, nx); b.st[0] = nloc; b.st[1] = nx; }
        const unsigned old = xb_add(&bar[XB_XSUB(b.x)], 1u);
        const unsigned gen = old / nloc;
        if (old + 1u == (gen + 1u) * nloc) {
            __builtin_amdgcn_fence(__ATOMIC_RELEASE, "agent");
            asm volatile("s_waitcnt vmcnt(0)" ::: "memory");
            const unsigned og = xb_add(&bar[XB_TOP], 1u);
            const unsigned tg = og / nx;
            if (og + 1u == (tg + 1u) * nx) xb_add(&bar[XB_TOPGEN], 1u);
            else XB_SPIN(xb_ld(&bar[XB_TOPGEN]) == tg, bar);
            __builtin_amdgcn_fence(__ATOMIC_ACQUIRE, "agent");
            xb_add(&bar[XB_XGEN(b.x)], 1u);
            asm volatile("s_waitcnt vmcnt(0)" ::: "memory");
        } else {
            XB_SPIN(xb_ld(&bar[XB_XGEN(b.x)]) == gen, bar);
            __builtin_amdgcn_fence(__ATOMIC_ACQUIRE, "agent");
            asm volatile("s_waitcnt vmcnt(0)" ::: "memory");
        }
    }
    __syncthreads();
}


__global__ void __launch_bounds__(NTHREADS, 2) mega(Params p) {
  cg::grid_group grid = cg::this_grid();
  __shared__ __attribute__((aligned(16))) char smem[SMEM_BYTES];
  if (threadIdx.x == 0) *(uint4*)(smem + SMEM_BYTES - 32) = make_uint4(0u, 0u, 0u, 0u);
  __syncthreads();
  XcdBarrier xb = xcd_barrier_post((unsigned*)(p.ws + OFF_BAR), (volatile LAS unsigned*)(smem + SMEM_BYTES - 32));
  int* census = (int*)(p.ws + OFF_BAR + 14336);
  if (threadIdx.x == 0) *(int*)(smem + SMEM_BYTES - 16) = atomicAdd(census + (xb.x & 15), 1);
  __syncthreads();
  int myrank = *(int*)(smem + SMEM_BYTES - 16);
  phase_prep(p, (float*)smem);
  if (threadIdx.x == 0) {
    int* modcnt = (int*)(p.ws + OFF_BAR + 15360);
    unsigned sp = 0;
    while (__hip_atomic_load(modcnt, __ATOMIC_RELAXED, __HIP_MEMORY_SCOPE_AGENT) < 192) {
      __builtin_amdgcn_s_sleep(2);
      if (++sp > (1u << 22)) break;
    }
    __builtin_amdgcn_fence(__ATOMIC_ACQUIRE, "agent");
    asm volatile("s_waitcnt vmcnt(0)" ::: "memory");
  }
  __syncthreads();
  phase_norm(p, 0, 0, false);
  if (p.ws == nullptr) grid.sync();
  xcd_barrier(xb);
  Loc lc;
  {
    bool ok = true;
    for (int j = 0; j < 16; j++) {
      int c = __hip_atomic_load(census + j, __ATOMIC_RELAXED, __HIP_MEMORY_SCOPE_AGENT);
      if (j < 8 ? (c <= 0) : (c != 0)) ok = false;
    }
    if (ok) { lc.xq = (int)xb.x; lc.lb = myrank; lc.nl = __hip_atomic_load(census + xb.x, __ATOMIC_RELAXED, __HIP_MEMORY_SCOPE_AGENT); }
    else { lc.xq = blockIdx.x & 7; lc.lb = blockIdx.x >> 3; lc.nl = gridDim.x >> 3; }
    lc.xq = __builtin_amdgcn_readfirstlane(lc.xq); lc.lb = __builtin_amdgcn_readfirstlane(lc.lb); lc.nl = __builtin_amdgcn_readfirstlane(lc.nl);
  }
#ifdef PROBE_SYNC10
  for (int i = 0; i < 10; i++) xcd_barrier(xb);
#endif
  for (int l = 0; l < 2; l++) {
    bool last = (l == 1);
    phase_inproj(p, l, (u16*)smem, lc);
    xcd_barrier(xb);
    phase_mix(p, l, last, smem, l, lc);
    xcd_barrier(xb);
#ifdef PROBE_MIX2
    phase_mix(p, l, last, smem, l + 2, lc, PROBE_MIX2);
    xcd_barrier(xb);
#endif
    phase_s5g(p, l, last);
    xcd_barrier(xb);
    phase_glu_pw(p, l, last, (u16*)smem);
    xcd_barrier(xb);
#ifdef PROBE_GLU2
    phase_glu_pw(p, l, last, (u16*)smem);
    xcd_barrier(xb);
#endif
    phase_outproj(p, l, last, (u16*)smem, lc);
    xcd_barrier(xb);
    phase_norm(p, l, 1, last);
    xcd_barrier(xb);
    phase_peerq(p, l, last, (u16*)smem, lc);
    xcd_barrier(xb);
#ifdef PROBE_PEERQ2
    phase_peerq(p, l, last, (u16*)smem, lc);
    xcd_barrier(xb);
#endif
#ifdef PROBE_GATHER2
    phase_gather(p, l, last, smem, true);
    xcd_barrier(xb);
#endif
    phase_gather(p, l, last, smem);
    if (!last) xcd_barrier(xb);
  }
}

extern "C" void kernel_launch(void* const* d_in, const int* in_sizes, int n_in,
                              void* d_out, int out_size, void* d_ws, size_t ws_size,
                              hipStream_t stream) {
  static int grid_blocks = 0;
  if (!grid_blocks) {
    int dev = 0, cus = 0, per_cu = 0;
    (void)hipGetDevice(&dev);
    (void)hipDeviceGetAttribute(&cus, hipDeviceAttributeMultiprocessorCount, dev);
    (void)hipOccupancyMaxActiveBlocksPerMultiprocessor(&per_cu, mega, NTHREADS, 0);
    if (per_cu > 2) per_cu = 2;
    if (per_cu < 1) per_cu = 1;
    grid_blocks = cus * per_cu;
  }
  Params p{};
  for (int i = 0; i < 35; i++) p.in[i] = (const float*)d_in[i];
  p.out = (float*)d_out;
  p.ws = (char*)d_ws;
  (void)hipMemsetAsync((char*)d_ws + OFF_BAR, 0, 16384, stream);
  void* args[] = {&p};
  hipError_t e = hipLaunchCooperativeKernel((void*)mega, dim3(grid_blocks), dim3(NTHREADS), args, 0, stream);
  if (e != hipSuccess) fprintf(stderr, "coop launch failed: %s (grid %d)\n", hipGetErrorString(e), grid_blocks);
}
```
